# Optimizing an MI355X kernel written in HIP

```python
import math
import jax, jax.numpy as jnp
from jax import lax
import numpy as np

D_MODEL = 1024
BATCH = 16
SEQ = 2048
DEPTH = 4

HEAD_DIM = 64
N_HEADS_SB = D_MODEL // (2 * HEAD_DIM)
N_HEADS_FOX = D_MODEL // (2 * HEAD_DIM)
N_HEADS_DIFF = D_MODEL // (2 * HEAD_DIM)
DIFF_V_DIM = 2 * HEAD_DIM
D_FF = ((8 * D_MODEL + 3 * 256 - 1) // (3 * 256)) * 256
N_BUCKETS = 32
MAX_DISTANCE = 128
Q_BLOCK = 128
RMS_EPS = 1e-6

SB_WIDTH = N_HEADS_SB * HEAD_DIM
FOX_WIDTH = N_HEADS_FOX * HEAD_DIM
EVEN_IN = 3 * SB_WIDTH + 3 * FOX_WIDTH + N_HEADS_FOX
EVEN_MIX = SB_WIDTH + FOX_WIDTH
DIFF_QK = N_HEADS_DIFF * 2 * HEAD_DIM
DIFF_V = N_HEADS_DIFF * DIFF_V_DIM
DIFF_IN = 2 * DIFF_QK + DIFF_V
N_EVEN = (DEPTH + 1) // 2
N_ODD = DEPTH // 2

kernel_name = "hybrid_stickbreak_fox_diffattn_trunk"


def rms_norm(x, g):
    xf = x.astype(jnp.float32)
    y = xf * lax.rsqrt(jnp.mean(xf * xf, axis=-1, keepdims=True) + RMS_EPS)
    return y * g.astype(jnp.float32)


def split_heads(t, n_heads, dim):
    b, s, _ = t.shape
    return t.reshape(b, s, n_heads, dim).transpose(0, 2, 1, 3)


def merge_heads(t):
    b, h, s, d = t.shape
    return t.transpose(0, 2, 1, 3).reshape(b, s, h * d)


def sweep_query_blocks(block_fn, seq_len):
    return jnp.concatenate(
        [block_fn(i * Q_BLOCK, (i + 1) * Q_BLOCK) for i in range(seq_len // Q_BLOCK)], axis=2)


def stick_breaking_attention(q, k, v):
    scale = HEAD_DIM ** -0.5

    def block(start, end):
        z = jnp.einsum('bhqd,bhkd->bhqk', q[:, :, start:end], k[:, :, :end]) * scale
        t_pos = jnp.arange(start, end)[:, None]
        s_pos = jnp.arange(end)[None, :]
        strict = s_pos < t_pos
        log_1m_beta = jnp.where(strict, jax.nn.log_sigmoid(-z), 0.0)
        between = lax.cumsum(log_1m_beta, axis=3, reverse=True) - log_1m_beta
        w = jnp.where(strict, jnp.exp(jax.nn.log_sigmoid(z) + between), 0.0)
        return jnp.einsum('bhqk,bhkd->bhqd', w, v[:, :, :end])

    return sweep_query_blocks(block, q.shape[2])


def forgetting_attention(q, k, v, log_f):
    scale = HEAD_DIM ** -0.5
    c = jnp.cumsum(log_f, axis=-1)

    def block(start, end):
        z = jnp.einsum('bhqd,bhkd->bhqk', q[:, :, start:end], k[:, :, :end]) * scale
        z = z + c[:, :, start:end, None] - c[:, :, None, :end]
        causal = jnp.arange(end)[None, :] <= jnp.arange(start, end)[:, None]
        p = jax.nn.softmax(jnp.where(causal, z, -jnp.inf), axis=-1)
        return jnp.einsum('bhqk,bhkd->bhqd', p, v[:, :, :end])

    return sweep_query_blocks(block, q.shape[2])


def t5_bucket(dist):
    max_exact = N_BUCKETS // 2
    nf = jnp.maximum(dist, 1).astype(jnp.float32)
    large = max_exact + (jnp.log(nf / max_exact) / math.log(MAX_DISTANCE / max_exact)
                         * (N_BUCKETS - max_exact)).astype(jnp.int32)
    large = jnp.minimum(large, N_BUCKETS - 1)
    return jnp.where(dist < max_exact, dist, large)


def differential_attention(q1, q2, k1, k2, v, lam, rel_bias):
    scale = HEAD_DIM ** -0.5
    table = rel_bias.astype(jnp.float32)

    def block(start, end):
        t_pos = jnp.arange(start, end)[:, None]
        s_pos = jnp.arange(end)[None, :]
        causal = s_pos <= t_pos
        bias = table[t5_bucket(jnp.maximum(t_pos - s_pos, 0))].transpose(2, 0, 1)[None]
        s1 = jnp.einsum('bhqd,bhkd->bhqk', q1[:, :, start:end], k1[:, :, :end]) * scale + bias
        s2 = jnp.einsum('bhqd,bhkd->bhqk', q2[:, :, start:end], k2[:, :, :end]) * scale + bias
        p1 = jax.nn.softmax(jnp.where(causal, s1, -jnp.inf), axis=-1)
        p2 = jax.nn.softmax(jnp.where(causal, s2, -jnp.inf), axis=-1)
        return jnp.einsum('bhqk,bhkd->bhqd', p1 - lam * p2, v[:, :, :end])

    return sweep_query_blocks(block, q1.shape[2])


def even_mixer(h, w_in, forget_b, gq, gk, w_out):
    proj = jnp.einsum('bsd,de->bse', h, w_in)
    cuts = [SB_WIDTH, 2 * SB_WIDTH, 3 * SB_WIDTH, 3 * SB_WIDTH + FOX_WIDTH,
            3 * SB_WIDTH + 2 * FOX_WIDTH, 3 * SB_WIDTH + 3 * FOX_WIDTH]
    qa, ka, va, qb, kb, vb, fg = jnp.split(proj, cuts, axis=-1)
    f32 = jnp.float32
    o_a = stick_breaking_attention(split_heads(qa, N_HEADS_SB, HEAD_DIM).astype(f32),
                                   split_heads(ka, N_HEADS_SB, HEAD_DIM).astype(f32),
                                   split_heads(va, N_HEADS_SB, HEAD_DIM).astype(f32))
    qb = rms_norm(split_heads(qb, N_HEADS_FOX, HEAD_DIM), gq)
    kb = rms_norm(split_heads(kb, N_HEADS_FOX, HEAD_DIM), gk)
    log_f = jax.nn.log_sigmoid(fg.astype(f32) + forget_b.astype(f32)).transpose(0, 2, 1)
    o_b = forgetting_attention(qb, kb, split_heads(vb, N_HEADS_FOX, HEAD_DIM).astype(f32), log_f)
    o = jnp.concatenate([merge_heads(o_a), merge_heads(o_b)], axis=-1).astype(h.dtype)
    return jnp.einsum('bse,ed->bsd', o, w_out)


def diff_mixer(h, w_in, gq, gk, lq1, lk1, lq2, lk2, subln_g, w_out, rel_bias, layer_idx):
    b, s, _ = h.shape
    proj = jnp.einsum('bsd,de->bse', h, w_in)
    q, k, v = jnp.split(proj, [DIFF_QK, 2 * DIFF_QK], axis=-1)
    q = rms_norm(q.reshape(b, s, N_HEADS_DIFF, 2, HEAD_DIM), gq)
    k = rms_norm(k.reshape(b, s, N_HEADS_DIFF, 2, HEAD_DIM), gk)
    q1, q2 = q[..., 0, :].transpose(0, 2, 1, 3), q[..., 1, :].transpose(0, 2, 1, 3)
    k1, k2 = k[..., 0, :].transpose(0, 2, 1, 3), k[..., 1, :].transpose(0, 2, 1, 3)
    v = split_heads(v, N_HEADS_DIFF, DIFF_V_DIM).astype(jnp.float32)
    lam_init = 0.8 - 0.6 * math.exp(-0.3 * layer_idx)
    f32 = jnp.float32
    lam = (jnp.exp(jnp.sum(lq1.astype(f32) * lk1.astype(f32)))
           - jnp.exp(jnp.sum(lq2.astype(f32) * lk2.astype(f32))) + lam_init)
    o = differential_attention(q1, q2, k1, k2, v, lam, rel_bias)
    o = rms_norm(o, subln_g) * (1.0 - lam_init)
    return jnp.einsum('bse,ed->bsd', merge_heads(o).astype(h.dtype), w_out)


def swiglu(h, w_gate, w_up, w_down):
    a = jnp.einsum('bsd,df->bsf', h, w_gate)
    u = jnp.einsum('bsd,df->bsf', h, w_up)
    return jnp.einsum('bsf,fd->bsd', jax.nn.silu(a) * u, w_down)


def setup_inputs(seed: int = 0) -> dict:
    key = jax.random.key(seed)
    ks = jax.random.split(key, 24)
    f32 = jnp.float32

    def dense(k, shape, fan_in):
        return jax.random.normal(k, shape, f32) * fan_in ** -0.5

    def gain(k, shape):
        return 1.0 + 0.02 * jax.random.normal(k, shape, f32)

    return {
        "x": jax.random.normal(ks[0], (BATCH, SEQ, D_MODEL), f32),
        "attn_norm_g": gain(ks[1], (DEPTH, D_MODEL)),
        "ffn_norm_g": gain(ks[2], (DEPTH, D_MODEL)),
        "even_w_in": dense(ks[3], (N_EVEN, D_MODEL, EVEN_IN), D_MODEL),
        "fox_forget_b": 3.0 + 0.5 * jax.random.normal(ks[4], (N_EVEN, N_HEADS_FOX), f32),
        "fox_q_norm_g": gain(ks[5], (N_EVEN, HEAD_DIM)),
        "fox_k_norm_g": gain(ks[6], (N_EVEN, HEAD_DIM)),
        "even_w_out": dense(ks[7], (N_EVEN, EVEN_MIX, D_MODEL), EVEN_MIX),
        "diff_w_in": dense(ks[8], (N_ODD, D_MODEL, DIFF_IN), D_MODEL),
        "diff_q_norm_g": gain(ks[9], (N_ODD, HEAD_DIM)),
        "diff_k_norm_g": gain(ks[10], (N_ODD, HEAD_DIM)),
        "diff_lambda_q1": 0.1 * jax.random.normal(ks[11], (N_ODD, HEAD_DIM), f32),
        "diff_lambda_k1": 0.1 * jax.random.normal(ks[12], (N_ODD, HEAD_DIM), f32),
        "diff_lambda_q2": 0.1 * jax.random.normal(ks[13], (N_ODD, HEAD_DIM), f32),
        "diff_lambda_k2": 0.1 * jax.random.normal(ks[14], (N_ODD, HEAD_DIM), f32),
        "diff_subln_g": gain(ks[15], (N_ODD, DIFF_V_DIM)),
        "diff_w_out": dense(ks[16], (N_ODD, DIFF_V, D_MODEL), DIFF_V),
        "rel_bias": 0.5 * jax.random.normal(ks[17], (N_BUCKETS, N_HEADS_DIFF), f32),
        "ffn_w_gate": dense(ks[18], (DEPTH, D_MODEL, D_FF), D_MODEL),
        "ffn_w_up": dense(ks[19], (DEPTH, D_MODEL, D_FF), D_MODEL),
        "ffn_w_down": dense(ks[20], (DEPTH, D_FF, D_MODEL), D_FF),
    }


def reference(x, attn_norm_g, ffn_norm_g, even_w_in, fox_forget_b, fox_q_norm_g, fox_k_norm_g,
              even_w_out, diff_w_in, diff_q_norm_g, diff_k_norm_g, diff_lambda_q1, diff_lambda_k1,
              diff_lambda_q2, diff_lambda_k2, diff_subln_g, diff_w_out, rel_bias,
              ffn_w_gate, ffn_w_up, ffn_w_down):
    for layer in range(DEPTH):
        h = rms_norm(x, attn_norm_g[layer]).astype(x.dtype)
        if layer % 2 == 0:
            e = layer // 2
            mix = even_mixer(h, even_w_in[e], fox_forget_b[e], fox_q_norm_g[e], fox_k_norm_g[e],
                             even_w_out[e])
        else:
            o = layer // 2
            mix = diff_mixer(h, diff_w_in[o], diff_q_norm_g[o], diff_k_norm_g[o],
                             diff_lambda_q1[o], diff_lambda_k1[o], diff_lambda_q2[o],
                             diff_lambda_k2[o], diff_subln_g[o], diff_w_out[o], rel_bias, layer)
        x = x + mix.astype(x.dtype)
        h = rms_norm(x, ffn_norm_g[layer]).astype(x.dtype)
        x = x + swiglu(h, ffn_w_gate[layer], ffn_w_up[layer], ffn_w_down[layer]).astype(x.dtype)
    return x
```

```cpp
#include <hip/hip_runtime.h>
#include <hip/hip_cooperative_groups.h>
#include <cstdio>
#include <cstdint>
namespace cg = cooperative_groups;
__device__ __forceinline__ float xor32f(float v) { const unsigned u = __builtin_bit_cast(unsigned, v); auto rr = __builtin_amdgcn_permlane32_swap(u, u, false, false); return __builtin_bit_cast(float, rr[0] ^ rr[1] ^ u); }
template <int MASK> __device__ __forceinline__ float shx(float v) {
    if (MASK == 32) return xor32f(v);
    return __builtin_bit_cast(float, __builtin_amdgcn_ds_swizzle(__builtin_bit_cast(int, v), (MASK << 10) | 0x1f));
}
__device__ __forceinline__ float shup(float v, int lane, int o) { return __builtin_bit_cast(float, __builtin_amdgcn_ds_bpermute(((lane - o) & 63) << 2, __builtin_bit_cast(int, v))); }
__device__ __forceinline__ int opaque_tid() { int t = (int)threadIdx.x; asm volatile("" : "+v"(t)); return t; }

namespace pg8 {
#define PG8_LAS __attribute__((address_space(3)))
typedef unsigned short bf16_t;
typedef short bf16x8 __attribute__((ext_vector_type(8)));
typedef float f32x4 __attribute__((ext_vector_type(4)));
typedef unsigned u32x4 __attribute__((ext_vector_type(4)));
constexpr int BM = 256, BK = 64, HALF = 128, HTB = HALF * BK * 2  , STAGE_BYTES = 8 * HTB, NXCD = 8, WGM = 8;

__host__ __device__ __forceinline__ int lds_byte(int r, int c) { const int st = (r >> 4) * 2 + (c >> 5), rr = r & 15, cc = c & 31, ob = rr * 64 + cc * 2; return st * 1024 + (ob ^ (((ob >> 9) & 1) << 5)); }
__host__ __device__ __forceinline__ void stage_rc(int b, int& R, int& C) { const int st = b / 1024, sb = b % 1024, swz = sb ^ (((sb >> 9) & 1) << 5); R = (st >> 1) * 16 + swz / 64; C = (st & 1) * 32 + (swz % 64) / 2; }
__host__ __device__ __forceinline__ int perm32(int rho) { const int n = rho >> 4, i = rho & 15; return 8 * (i >> 2) + 4 * n + (i & 3); }

struct Unit { int pm, pn; };
struct Gemm { const bf16_t* A; const bf16_t* Bt; int M, N, K; };

struct StaticOrder {
    int nM, nN, nwg, G, c;
    __host__ __device__ void init(int M, int N, int G_, int c_) { nM = M / BM; nN = N / BM; nwg = nM * nN; G = G_; c = c_; }
    __host__ __device__ bool next(int i, Unit& u) const {
        const long L = (long)i * G + c; if (L >= nwg) return false;
        int wgid = (int)L; { const int q = nwg / NXCD, r = nwg % NXCD, xcd = wgid % NXCD, off = wgid / NXCD; wgid = (xcd < r ? xcd * (q + 1) : r * (q + 1) + (xcd - r) * q) + off; }
        const int nig = WGM * nN, gid = wgid / nig, fm = gid * WGM, gsz = (nM - fm) < WGM ? (nM - fm) : WGM;
        u.pm = fm + ((wgid % nig) % gsz); u.pn = (wgid % nig) / gsz; return true;
    }
    __device__ __forceinline__ void a_ready(const Unit&) const {}
    __device__ __forceinline__ void done(const Unit&) const {}
};

typedef float f32x2 __attribute__((ext_vector_type(2)));
typedef __bf16 bf16x2_t __attribute__((ext_vector_type(2)));
typedef unsigned u32x2 __attribute__((ext_vector_type(2)));
__device__ __forceinline__ unsigned cvtpk(float lo, float hi) { f32x2 v = {lo, hi}; bf16x2_t b = __builtin_convertvector(v, bf16x2_t); return __builtin_bit_cast(unsigned, b); }
constexpr float RMS_EPS_F = 1e-6f;
constexpr float LOG2E_F = 1.4426950408889634f;
constexpr float C2_F = 0.125f * LOG2E_F;
__device__ __forceinline__ void load_rstd(const float* ssq, int row0, int fq, float (&rs)[2][4]) {
#pragma unroll
    for (int ai = 0; ai < 2; ++ai)
#pragma unroll
        for (int m = 0; m < 4; ++m) {
            const f32x4 v = *(const f32x4*)(ssq + (size_t)(row0 + ai * HALF + m * 16) * 16 + 4 * fq);
            float s = (v[0] + v[1]) + (v[2] + v[3]);
            s += shx<16>(s); s += shx<32>(s);
            rs[ai][m] = rsqrtf(s * (1.0f / 1024.0f) + RMS_EPS_F);
        }
}
struct EpiQKV {
    static constexpr bool PERM = true, AFTER_DRAIN = false;
    bf16_t* Q; const float* ssq; const float* gq; const float* gk; int odd;
    __device__ __forceinline__ void operator()(const f32x4 (&acc)[2][2][4][2], const Unit& u, int wr, int wc, int fr, int fq) const {
        const int buf = u.pn >> 2, pl = u.pn & 3;
        const int row0 = u.pm * BM + wr * 64 + fr;
        const int colbase = 256 * pl + 64 * wc + 8 * fq;
        bf16_t* base = Q + (size_t)buf * (size_t)(32u << 20);
        const bool norm = (buf < 2) && (odd || pl >= 2);
        const float sc = (buf == 0) ? C2_F : 1.0f;
        const float* g = gq + ((buf == 0) ? 0 : (gk - gq));
        const f32x4 one4 = (f32x4){1.f, 1.f, 1.f, 1.f};
        const float* gp = g + 8 * fq;
        const f32x4 g00 = (norm ? *(const f32x4*)(gp) : one4) * sc, g01 = (norm ? *(const f32x4*)(gp + 4) : one4) * sc;
        const f32x4 g10 = (norm ? *(const f32x4*)(gp + 32) : one4) * sc, g11 = (norm ? *(const f32x4*)(gp + 36) : one4) * sc;
        float rs[2][4]; load_rstd(ssq, row0, fq, rs);
#pragma unroll
        for (int ai = 0; ai < 2; ++ai)
#pragma unroll
            for (int m = 0; m < 4; ++m) {
                float mul = rs[ai][m];
                if (norm) {
                    float ss = 0.f;
#pragma unroll
                    for (int bj = 0; bj < 2; ++bj)
#pragma unroll
                        for (int n = 0; n < 2; ++n) { const f32x4 x = acc[ai][bj][m][n]; ss += (x[0] * x[0] + x[1] * x[1]) + (x[2] * x[2] + x[3] * x[3]); }
                    ss += shx<16>(ss); ss += shx<32>(ss);
                    mul *= rsqrtf(ss * mul * mul * (1.0f / 64.0f) + RMS_EPS_F);
                }
                bf16_t* rowp = base + (size_t)(row0 + ai * HALF + m * 16) * 1024 + colbase;
                {   const f32x4 v0 = acc[ai][0][m][0] * mul * g00, v1 = acc[ai][0][m][1] * mul * g01;
                    u32x4 w; w.x = cvtpk(v0[0], v0[1]); w.y = cvtpk(v0[2], v0[3]); w.z = cvtpk(v1[0], v1[1]); w.w = cvtpk(v1[2], v1[3]);
                    *(u32x4*)(rowp) = w; }
                {   const f32x4 v0 = acc[ai][1][m][0] * mul * g10, v1 = acc[ai][1][m][1] * mul * g11;
                    u32x4 w; w.x = cvtpk(v0[0], v0[1]); w.y = cvtpk(v0[2], v0[3]); w.z = cvtpk(v1[0], v1[1]); w.w = cvtpk(v1[2], v1[3]);
                    *(u32x4*)(rowp + 32) = w; }
            }
    }
};
struct EpiSwiGLU {
    static constexpr bool PERM = true, AFTER_DRAIN = false;
    bf16_t* H; const float* ssq;
    __device__ __forceinline__ void operator()(const f32x4 (&acc)[2][2][4][2], const Unit& u, int wr, int wc, int fr, int fq) const {
        const int row0 = u.pm * BM + wr * 64 + fr;
        const int col0 = 128 * u.pn + 32 * wc + 8 * fq;
        float rs[2][4]; load_rstd(ssq, row0, fq, rs);
#pragma unroll
        for (int ai = 0; ai < 2; ++ai)
#pragma unroll
            for (int m = 0; m < 4; ++m) {
                const float mul = rs[ai][m], nml = -mul * LOG2E_F, mul2 = mul * mul;
                float hv[8];
#pragma unroll
                for (int n = 0; n < 2; ++n)
#pragma unroll
                    for (int i = 0; i < 4; ++i) {
                        const float ag = acc[ai][0][m][n][i];
                        const float e = __builtin_amdgcn_exp2f(ag * nml);
                        hv[4 * n + i] = (ag * acc[ai][1][m][n][i]) * (mul2 * __builtin_amdgcn_rcpf(1.0f + e));
                    }
                u32x4 w; w.x = cvtpk(hv[0], hv[1]); w.y = cvtpk(hv[2], hv[3]); w.z = cvtpk(hv[4], hv[5]); w.w = cvtpk(hv[6], hv[7]);
                *(u32x4*)(H + (size_t)(row0 + ai * HALF + m * 16) * 2816 + col0) = w;
            }
    }
};
struct EpiResid {
    static constexpr bool PERM = true, AFTER_DRAIN = false;
    bf16_t* xb; float* out; float* ssq_out; int last;
    __device__ __forceinline__ void operator()(const f32x4 (&acc)[2][2][4][2], const Unit& u, int wr, int wc, int fr, int fq) const {
        const int row0 = u.pm * BM + wr * 64 + fr;
        const int col0 = u.pn * BM + wc * 32 + 8 * fq;
        u32x4 w[2][4][2];
#pragma unroll
        for (int ai = 0; ai < 2; ++ai)
#pragma unroll
            for (int m = 0; m < 4; ++m)
#pragma unroll
                for (int bj = 0; bj < 2; ++bj) w[ai][m][bj] = *(const u32x4*)(xb + (size_t)(row0 + ai * HALF + m * 16) * 1024 + col0 + bj * HALF);
#pragma unroll
        for (int ai = 0; ai < 2; ++ai)
#pragma unroll
            for (int m = 0; m < 4; ++m) {
                const int row = row0 + ai * HALF + m * 16;
                const size_t off = (size_t)row * 1024 + col0;
                float ss = 0.f;
#pragma unroll
                for (int bj = 0; bj < 2; ++bj) {
                    const u32x4 wv = w[ai][m][bj];
                    f32x4 o0 = acc[ai][bj][m][0], o1 = acc[ai][bj][m][1];
                    o0[0] += __builtin_bit_cast(float, wv.x << 16); o0[1] += __builtin_bit_cast(float, wv.x & 0xffff0000u); o0[2] += __builtin_bit_cast(float, wv.y << 16); o0[3] += __builtin_bit_cast(float, wv.y & 0xffff0000u);
                    o1[0] += __builtin_bit_cast(float, wv.z << 16); o1[1] += __builtin_bit_cast(float, wv.z & 0xffff0000u); o1[2] += __builtin_bit_cast(float, wv.w << 16); o1[3] += __builtin_bit_cast(float, wv.w & 0xffff0000u);
                    if (last) { *(f32x4*)(out + off + bj * HALF) = o0; *(f32x4*)(out + off + bj * HALF + 4) = o1; }
                    else {
                        u32x4 v; v.x = cvtpk(o0[0], o0[1]); v.y = cvtpk(o0[2], o0[3]); v.z = cvtpk(o1[0], o1[1]); v.w = cvtpk(o1[2], o1[3]);
                        *(u32x4*)(xb + off + bj * HALF) = v;
                        ss += (o0[0] * o0[0] + o0[1] * o0[1]) + (o0[2] * o0[2] + o0[3] * o0[3]) + (o1[0] * o1[0] + o1[1] * o1[1]) + (o1[2] * o1[2] + o1[3] * o1[3]);
                    }
                }
                if (!last) {
                    ss += __shfl_xor(ss, 16); ss += __shfl_xor(ss, 32);
                    if (fq == 0) ssq_out[(size_t)row * 16 + 4 * u.pn + wc] = ss;
                }
            }
    }
};
template <class Epi, class Sched, bool ALIGN_EPI = false, bool SP2 = false>
__device__ __forceinline__ void gemm_phase(PG8_LAS unsigned char* lds, const Gemm g, const Sched& S, const Epi& E) {
    const int tid = opaque_tid(), wid = __builtin_amdgcn_readfirstlane(tid >> 6), lane = tid & 63, wr = wid >> 2, wc = wid & 3, fr = lane & 15, fq = lane >> 4;
    const int K = g.K, nt = K / BK;
    unsigned voffA[2], voffB[2];
#pragma unroll
    for (int i = 0; i < 2; ++i) { int R, C; stage_rc(tid * 16 + i * 8192, R, C); const int Rb = Epi::PERM ? ((R & ~31) + perm32(R & 31)) : R;
        voffA[i] = (unsigned)(R * K + C) * 2u; voffB[i] = (unsigned)(Rb * K + C) * 2u; }
    const size_t kstep = (size_t)(BK * 2);
    const size_t hstep = (size_t)HALF * K * 2;
    const size_t tstep = 2 * hstep;
    const unsigned ldsw = (unsigned)wid * 1024u;
    const int aoff = lds_byte(wr * 64 + fr, fq * 8), boff = lds_byte(wc * 32 + fr, fq * 8);
#define PG8_SA(b, h) (((b) * 2 + (h)) * HTB)
#define PG8_SB(b, h) ((4 + (b) * 2 + (h)) * HTB)
#define PG8_STAGE(bufoff, gbase, voff) do { _Pragma("unroll") for (int _i = 0; _i < 2; ++_i) \
        __builtin_amdgcn_global_load_lds((const unsigned*)((const char*)(gbase) + (voff)[_i]), (PG8_LAS unsigned*)(lds + (bufoff) + ldsw + _i * 8192), 16, 0, 0); } while (0)
#define PG8_LDA(dst, b, h) do { _Pragma("unroll") for (int m = 0; m < 4; ++m) _Pragma("unroll") for (int k = 0; k < 2; ++k) dst[m][k] = *(const PG8_LAS bf16x8*)(lds + PG8_SA(b, h) + aoff + m * 2048 + k * 1024); } while (0)
#define PG8_LDB(dst, b, h) do { _Pragma("unroll") for (int n = 0; n < 2; ++n) _Pragma("unroll") for (int k = 0; k < 2; ++k) dst[n][k] = *(const PG8_LAS bf16x8*)(lds + PG8_SB(b, h) + boff + n * 2048 + k * 1024); } while (0)
#define PG8_MMA(ai, bj, At, Bt) do { __builtin_amdgcn_s_setprio(1); _Pragma("unroll") for (int m = 0; m < 4; ++m) _Pragma("unroll") for (int n = 0; n < 2; ++n) _Pragma("unroll") for (int k = 0; k < 2; ++k) \
        acc[ai][bj][m][n] = __builtin_amdgcn_mfma_f32_16x16x32_bf16(Bt[n][k], At[m][k], acc[ai][bj][m][n], 0, 0, 0); __builtin_amdgcn_s_setprio(0); } while (0)
#define PG8_WAIT_V(n) asm volatile("s_waitcnt vmcnt(" #n ")" ::: "memory")
#define PG8_WAIT_L(n) asm volatile("s_waitcnt lgkmcnt(" #n ")" ::: "memory")
#define PG8_BAR __builtin_amdgcn_s_barrier()
#define PG8_SCHED __builtin_amdgcn_sched_barrier(0)
    Unit cur, nxt; int ui = 0;
    if (!S.next(0, cur)) return;
    f32x4 acc[2][2][4][2];
#pragma unroll
    for (int a = 0; a < 2; ++a)
#pragma unroll
        for (int b = 0; b < 2; ++b)
#pragma unroll
            for (int m = 0; m < 4; ++m)
#pragma unroll
                for (int n = 0; n < 2; ++n) acc[a][b][m][n] = (f32x4){0.f, 0.f, 0.f, 0.f};
    bf16x8 At[4][2], B0[2][2], B1[2][2];
    const char* cA = (const char*)g.A + (size_t)cur.pm * tstep; const char* cB = (const char*)g.Bt + (size_t)cur.pn * tstep;
    S.a_ready(cur);
    if constexpr (SP2) {
        PG8_STAGE(PG8_SB(0, 0), cB, voffB); PG8_STAGE(PG8_SB(0, 1), cB + hstep, voffB); PG8_STAGE(PG8_SA(0, 0), cA, voffA); PG8_STAGE(PG8_SA(0, 1), cA + hstep, voffA);
        if (wr == 1) PG8_BAR;
        PG8_WAIT_V(2); PG8_BAR;
        PG8_STAGE(PG8_SB(1, 0), cB + kstep, voffB); PG8_STAGE(PG8_SA(1, 0), cA + kstep, voffA); PG8_STAGE(PG8_SB(1, 1), cB + hstep + kstep, voffB);
        PG8_WAIT_V(6); PG8_BAR;
    } else {
        PG8_STAGE(PG8_SB(0, 0), cB, voffB); PG8_STAGE(PG8_SA(0, 0), cA, voffA); PG8_STAGE(PG8_SB(0, 1), cB + hstep, voffB); PG8_STAGE(PG8_SA(0, 1), cA + hstep, voffA);
        if (wr == 1) PG8_BAR;
        PG8_WAIT_V(4); PG8_BAR;
        PG8_STAGE(PG8_SB(1, 0), cB + kstep, voffB); PG8_STAGE(PG8_SA(1, 0), cA + kstep, voffA); PG8_STAGE(PG8_SB(1, 1), cB + hstep + kstep, voffB);
        PG8_WAIT_V(6); PG8_BAR;
    }
    for (;;) {
        const bool has_next = S.next(ui + 1, nxt);
        const char* nA = has_next ? (const char*)g.A + (size_t)nxt.pm * tstep : cA; const char* nB = has_next ? (const char*)g.Bt + (size_t)nxt.pn * tstep : cB;
        for (int t = 0; t < nt; t += 2) {
            const bool last = (t == nt - 2);
            const char* a1 = cA + (size_t)(t + 1) * kstep;
            const char* a2 = last ? nA : cA + (size_t)(t + 2) * kstep; const char* b2 = last ? nB : cB + (size_t)(t + 2) * kstep;
            const char* a3 = a2 + kstep; const char* b3 = b2 + kstep;
            if (last && has_next) S.a_ready(nxt);
            if constexpr (SP2) {
            PG8_LDB(B0, 0, 0); PG8_LDB(B1, 0, 1); PG8_SCHED; PG8_LDA(At, 0, 0); PG8_STAGE(PG8_SA(1, 1), a1 + hstep, voffA);
            PG8_WAIT_V(8); PG8_WAIT_L(0); PG8_BAR; PG8_MMA(0, 0, At, B0); PG8_MMA(0, 1, At, B1); PG8_BAR; PG8_SCHED;
            PG8_LDA(At, 0, 1); PG8_STAGE(PG8_SB(0, 0), b2, voffB); PG8_STAGE(PG8_SB(0, 1), b2 + hstep, voffB); PG8_STAGE(PG8_SA(0, 0), a2, voffA);
            PG8_WAIT_V(8); PG8_WAIT_L(0); PG8_BAR; PG8_MMA(1, 0, At, B0); PG8_MMA(1, 1, At, B1); PG8_BAR; PG8_SCHED;
            PG8_LDB(B0, 1, 0); PG8_LDB(B1, 1, 1); PG8_SCHED; PG8_LDA(At, 1, 0); PG8_STAGE(PG8_SA(0, 1), a2 + hstep, voffA);
            PG8_WAIT_V(8); PG8_WAIT_L(0); PG8_BAR; PG8_MMA(0, 0, At, B0); PG8_MMA(0, 1, At, B1); PG8_BAR; PG8_SCHED;
            PG8_LDA(At, 1, 1); PG8_STAGE(PG8_SB(1, 0), b3, voffB); PG8_STAGE(PG8_SB(1, 1), b3 + hstep, voffB); PG8_STAGE(PG8_SA(1, 0), a3, voffA);
            PG8_WAIT_V(8); PG8_WAIT_L(0); PG8_BAR; PG8_MMA(1, 0, At, B0); PG8_MMA(1, 1, At, B1); PG8_BAR; PG8_SCHED;
            } else {
            PG8_LDB(B0, 0, 0); PG8_SCHED; PG8_LDA(At, 0, 0); PG8_STAGE(PG8_SA(1, 1), a1 + hstep, voffA);
            PG8_WAIT_L(8); PG8_BAR; PG8_WAIT_L(0); PG8_MMA(0, 0, At, B0); PG8_BAR; PG8_SCHED;
            PG8_LDB(B1, 0, 1); PG8_STAGE(PG8_SB(0, 0), b2, voffB);
            PG8_BAR; PG8_WAIT_L(0); PG8_MMA(0, 1, At, B1); PG8_BAR;
            PG8_LDA(At, 0, 1); PG8_STAGE(PG8_SA(0, 0), a2, voffA);
            PG8_BAR; PG8_WAIT_L(0); PG8_MMA(1, 0, At, B0); PG8_BAR; PG8_SCHED;
            PG8_STAGE(PG8_SB(0, 1), b2 + hstep, voffB);
            PG8_WAIT_V(6); PG8_BAR; PG8_MMA(1, 1, At, B1); PG8_BAR;
            PG8_LDB(B0, 1, 0); PG8_SCHED; PG8_LDA(At, 1, 0); PG8_STAGE(PG8_SA(0, 1), a2 + hstep, voffA);
            PG8_WAIT_L(8); PG8_BAR; PG8_WAIT_L(0); PG8_MMA(0, 0, At, B0); PG8_BAR; PG8_SCHED;
            PG8_LDB(B1, 1, 1); PG8_STAGE(PG8_SB(1, 0), b3, voffB);
            PG8_BAR; PG8_WAIT_L(0); PG8_MMA(0, 1, At, B1); PG8_BAR;
            PG8_LDA(At, 1, 1); PG8_STAGE(PG8_SA(1, 0), a3, voffA);
            PG8_BAR; PG8_WAIT_L(0); PG8_MMA(1, 0, At, B0); PG8_BAR; PG8_SCHED;
            PG8_STAGE(PG8_SB(1, 1), b3 + hstep, voffB);
            PG8_WAIT_V(6); PG8_BAR; PG8_MMA(1, 1, At, B1); PG8_BAR;
            }
        }
        if constexpr (ALIGN_EPI) { if (wr == 0) PG8_BAR; }
        if constexpr (!Epi::AFTER_DRAIN) { E(acc, cur, wr, wc, fr, fq); S.done(cur); }
        if (!has_next) break;
#pragma unroll
        for (int a = 0; a < 2; ++a)
#pragma unroll
            for (int b = 0; b < 2; ++b)
#pragma unroll
                for (int m = 0; m < 4; ++m)
#pragma unroll
                    for (int n = 0; n < 2; ++n) acc[a][b][m][n] = (f32x4){0.f, 0.f, 0.f, 0.f};
        cur = nxt; cA = nA; cB = nB; ++ui;
        if constexpr (ALIGN_EPI) { if (wr == 1) PG8_BAR; }
    }
    PG8_WAIT_V(0);
    if constexpr (!ALIGN_EPI) { if (wr == 0) PG8_BAR; }
    PG8_BAR;
    if constexpr (Epi::AFTER_DRAIN) { E.fused(acc, cur, wr, wc, fr, fq, lds, wid, lane); S.done(cur); }
#undef PG8_SA
#undef PG8_SB
#undef PG8_STAGE
#undef PG8_LDA
#undef PG8_LDB
#undef PG8_MMA
#undef PG8_WAIT_V
#undef PG8_WAIT_L
#undef PG8_BAR
#undef PG8_SCHED
}
}
#ifndef PG8_SP2
#define PG8_SP2 true
#endif
#ifndef PG8_ALIGN
#define PG8_ALIGN true
#endif

constexpr int BATCH = 16, SEQ = 2048, DMODEL = 1024, DEPTH = 4, DFF = 2816, MTOK = BATCH * SEQ;
constexpr int EVEN_IN = 3080, DIFF_IN = 3072;
constexpr float RMS_EPS = 1e-6f, LOG2E = 1.4426950408889634f, C2 = 0.125f * LOG2E;
#define LAS __attribute__((address_space(3)))
typedef unsigned short bf16;
typedef short bf16x8 __attribute__((ext_vector_type(8)));
typedef float f32x4 __attribute__((ext_vector_type(4)));
typedef float f32x16 __attribute__((ext_vector_type(16)));
typedef unsigned u32x4 __attribute__((ext_vector_type(4)));
typedef unsigned u32x2 __attribute__((ext_vector_type(2)));
typedef short v4i16_t __attribute__((ext_vector_type(4)));
using pg8::cvtpk;

constexpr size_t MiB = 1u << 20;
constexpr size_t WS_W = 0, W_LAYER = 25 * MiB, W_IN = 0, W_O = 6 * MiB, W_GU = 8 * MiB, W_D = 19 * MiB;
constexpr size_t WS_XB = 100 * MiB;
constexpr size_t WS_Q = 164 * MiB, WS_K = 228 * MiB, WS_V = 292 * MiB, WS_O = 356 * MiB;
constexpr size_t WS_H = 164 * MiB;
constexpr size_t WS_SSQA = 420 * MiB, WS_SSQF = 422 * MiB;
constexpr size_t WS_CL = 424 * MiB, WS_TOT = 425 * MiB;
constexpr size_t WS_BAR = 426 * MiB;
constexpr size_t WS_FGW = 427 * MiB;
constexpr size_t WS_END = 428 * MiB;
static_assert(WS_K - WS_Q == 64 * MiB && WS_V - WS_K == 64 * MiB, "EpiQKV strides");
static_assert(WS_H + (size_t)MTOK * DFF * 2 <= WS_O, "hidden overlay");

struct Params {
    const float* x; const float* attn_g; const float* ffn_g; const float* even_w_in; const float* fox_b; const float* fox_gq; const float* fox_gk; const float* even_w_out;
    const float* diff_w_in; const float* diff_gq; const float* diff_gk; const float* lq1; const float* lk1; const float* lq2; const float* lk2; const float* subln_g; const float* diff_w_out;
    const float* rel_bias; const float* w_gate; const float* w_up; const float* w_down;
    float* out; unsigned char* ws;
};

typedef const __attribute__((address_space(4))) Params* KP;
__device__ __forceinline__ int opaque_bx() { int b = (int)blockIdx.x; asm volatile("" : "+s"(b)); return b; }
__device__ __forceinline__ KP kparams() { KP p = (KP)__builtin_amdgcn_kernarg_segment_ptr(); asm volatile("" : "+s"(p)); return p; }
template <int CTRL> __device__ __forceinline__ float dppf(float v) { return __builtin_bit_cast(float, __builtin_amdgcn_update_dpp(0, __builtin_bit_cast(int, v), CTRL, 0xF, 0xF, true)); }
__device__ __forceinline__ float wave_sum(float v) {
    v += dppf<0xB1>(v);
    v += dppf<0x4E>(v);
    v += dppf<0x141>(v);
    v += dppf<0x140>(v);
    v += shx<16>(v); v += shx<32>(v);
    return v;
}
__device__ __forceinline__ unsigned f2bf(float f) { unsigned u = __builtin_bit_cast(unsigned, f); return (u + 0x7fffu + ((u >> 16) & 1u)) >> 16; }
__device__ __forceinline__ float bf2f(unsigned b) { return __builtin_bit_cast(float, b << 16); }

struct TrItem { const float* W; const float* g; bf16* WT; int ldw, src, K, dst, k0; };
__device__ __forceinline__ TrItem tr_decode(KP P, int it) {
    constexpr int I_IN = 16 * 96, I_O = 16 * 32, I_GU = 16 * 176, I_D = 44 * 32, I_LAYER = I_IN + I_O + I_GU + I_D;
    const int L = it / I_LAYER; int r = it % I_LAYER; const int eo = L >> 1, odd = L & 1;
    unsigned char* wl = P->ws + WS_W + (size_t)L * W_LAYER;
    TrItem d;
    if (r < I_IN) {
        const int kb = r / 96, nb = r % 96, pn = nb >> 3, q8 = nb & 7, bj = q8 >> 2, wc = q8 & 3, buf = pn >> 2;
        const int c = 256 * (pn & 3) + 64 * wc + 32 * bj;
        if (odd) { d.src = buf * 1024 + c; d.W = P->diff_w_in + (size_t)eo * DMODEL * DIFF_IN; d.ldw = DIFF_IN; }
        else { d.src = (c < 512 ? 0 : 1536) + buf * 512 + (c & 511); d.W = P->even_w_in + (size_t)eo * DMODEL * EVEN_IN; d.ldw = EVEN_IN; }
        d.g = P->attn_g + L * DMODEL; d.WT = (bf16*)(wl + W_IN); d.K = 1024; d.dst = 32 * nb; d.k0 = 64 * kb; return d;
    }
    r -= I_IN;
    if (r < I_O) {
        const int kb = r / 32, nb = r % 32;
        d.W = (odd ? P->diff_w_out : P->even_w_out) + (size_t)eo * 1024 * 1024; d.ldw = 1024; d.src = 32 * nb; d.g = nullptr; d.WT = (bf16*)(wl + W_O); d.K = 1024; d.dst = 32 * nb; d.k0 = 64 * kb; return d;
    }
    r -= I_O;
    if (r < I_GU) {
        const int kb = r / 176, nb = r % 176, pn = nb >> 3, q8 = nb & 7, bj = q8 >> 2, wc = q8 & 3;
        d.W = (bj ? P->w_up : P->w_gate) + (size_t)L * DMODEL * DFF; d.ldw = DFF; d.src = 128 * pn + 32 * wc; d.g = P->ffn_g + L * DMODEL; d.WT = (bf16*)(wl + W_GU); d.K = 1024; d.dst = 32 * nb; d.k0 = 64 * kb; return d;
    }
    r -= I_GU;
    { const int kb = r / 32, nb = r % 32;
      d.W = P->w_down + (size_t)L * DFF * DMODEL; d.ldw = 1024; d.src = 32 * nb; d.g = nullptr; d.WT = (bf16*)(wl + W_D); d.K = DFF; d.dst = 32 * nb; d.k0 = 64 * kb; return d; }
}
__device__ __forceinline__ void tr_load(const TrItem& d, float (&v)[32], f32x4& g0, f32x4& g1, int lane) {
    const float* wp = d.W + (size_t)(d.k0 + (lane >> 5)) * d.ldw + d.src + (lane & 31);
#pragma unroll
    for (int i = 0; i < 32; ++i) v[i] = wp[(size_t)(2 * i) * d.ldw];
    g0 = (f32x4){1.f, 1.f, 1.f, 1.f}; g1 = g0;
    if (d.g) { const float* gp = d.g + d.k0 + 8 * (lane & 7); g0 = *(const f32x4*)gp; g1 = *(const f32x4*)(gp + 4); }
}
__device__ __forceinline__ void tr_finish(const TrItem& d, const float (&v)[32], const f32x4 g0, const f32x4 g1, LAS float* scr, int lane) {
#pragma unroll
    for (int i = 0; i < 32; ++i) scr[(2 * i + (lane >> 5)) * 33 + (lane & 31)] = v[i];
    asm volatile("s_waitcnt lgkmcnt(0)" ::: "memory");
    const int c = lane & 7;
#pragma unroll
    for (int j = 0; j < 4; ++j) { const int n = (lane >> 3) + 8 * j; const LAS float* s = scr + (8 * c) * 33 + n;
        u32x4 o; o.x = cvtpk(s[0 * 33] * g0[0], s[1 * 33] * g0[1]); o.y = cvtpk(s[2 * 33] * g0[2], s[3 * 33] * g0[3]); o.z = cvtpk(s[4 * 33] * g1[0], s[5 * 33] * g1[1]); o.w = cvtpk(s[6 * 33] * g1[2], s[7 * 33] * g1[3]);
        *(u32x4*)(d.WT + (size_t)(d.dst + n) * d.K + d.k0 + 8 * c) = o; }
    asm volatile("s_waitcnt lgkmcnt(0)" ::: "memory");
}
__device__ __forceinline__ void p0_prologue(LAS unsigned char* lds) {
    const KP P = kparams(); const int tid = opaque_tid(), lane = tid & 63, wave = __builtin_amdgcn_readfirstlane(tid >> 6);
    LAS float* scr = (LAS float*)(lds + wave * 16384);
    const int gw = opaque_bx() * 8 + wave, NGW = 256 * 8;
    constexpr int NITEMS = DEPTH * (16 * 96 + 16 * 32 + 16 * 176 + 44 * 32);
    {   TrItem cur = tr_decode(P, gw); float v[32]; f32x4 g0, g1;
        tr_load(cur, v, g0, g1, lane);
#pragma unroll 1
        for (int it = gw; it < NITEMS; it += NGW) {
            const bool hn = it + NGW < NITEMS;
            TrItem nxt = cur; float vn[32]; f32x4 h0 = g0, h1 = g1;
#pragma unroll
            for (int i = 0; i < 32; ++i) vn[i] = 0.f;
            if (hn) { nxt = tr_decode(P, it + NGW); tr_load(nxt, vn, h0, h1, lane); }
            tr_finish(cur, v, g0, g1, scr, lane);
            cur = nxt; g0 = h0; g1 = h1;
#pragma unroll
            for (int i = 0; i < 32; ++i) v[i] = vn[i];
        }
    }
    for (int idx = gw * 64 + lane; idx < 2 * 32 * 1024; idx += NGW * 64) { const int e = idx >> 15, n = (idx >> 10) & 31, k = idx & 1023;
        const float v = n < 8 ? P->even_w_in[(size_t)e * DMODEL * EVEN_IN + (size_t)k * EVEN_IN + 3072 + n] * P->attn_g[2 * e * DMODEL + k] : 0.f;
        ((bf16*)(P->ws + WS_FGW))[idx] = (bf16)(cvtpk(v, 0.f) & 0xffffu); }
    bf16* XB = (bf16*)(P->ws + WS_XB); float* ssq = (float*)(P->ws + WS_SSQA);
    {
        f32x4 v[2][4];
#pragma unroll
        for (int rr = 0; rr < 2; ++rr) { const f32x4* xr = (const f32x4*)(P->x + (size_t)(gw + rr * NGW) * DMODEL) + lane;
#pragma unroll
            for (int j = 0; j < 4; ++j) v[rr][j] = xr[64 * j]; }
#pragma unroll 1
        for (int m0 = gw; m0 < MTOK; m0 += 2 * NGW) {
            f32x4 vn[2][4];
            const bool hn = m0 + 2 * NGW < MTOK; const int mn = hn ? m0 + 2 * NGW : m0;
#pragma unroll
            for (int rr = 0; rr < 2; ++rr) { const f32x4* xr = (const f32x4*)(P->x + (size_t)(mn + rr * NGW) * DMODEL) + lane;
#pragma unroll
                for (int j = 0; j < 4; ++j) vn[rr][j] = xr[64 * j]; }
#pragma unroll
            for (int rr = 0; rr < 2; ++rr) { const int m = m0 + rr * NGW; float s = 0.f;
                unsigned long long* o8 = (unsigned long long*)(XB + (size_t)m * DMODEL) + lane;
#pragma unroll
                for (int j = 0; j < 4; ++j) { const f32x4 x = v[rr][j]; s += (x[0] * x[0] + x[1] * x[1]) + (x[2] * x[2] + x[3] * x[3]);
                    o8[64 * j] = (unsigned long long)cvtpk(x[0], x[1]) | ((unsigned long long)cvtpk(x[2], x[3]) << 32); }
                s = wave_sum(s);
                if (lane < 16) ssq[(size_t)m * 16 + lane] = (lane == 0) ? s : 0.f; }
#pragma unroll
            for (int rr = 0; rr < 2; ++rr)
#pragma unroll
                for (int j = 0; j < 4; ++j) v[rr][j] = vn[rr][j];
        }
    }
}

__device__ __forceinline__ void fg_phase(LAS unsigned char* lds, int L) {
    const KP P = kparams(); const int tid = opaque_tid(), lane = tid & 63, wave = __builtin_amdgcn_readfirstlane(tid >> 6);
    const int e = L >> 1, r32 = lane & 31, hi = lane >> 5;
    LAS float* lf = (LAS float*)lds;
    LAS f32x4* part = (LAS f32x4*)(lds + 4096);
    LAS unsigned char* wst = lds + 8192;
    unsigned char* ws = P->ws;
    { const bf16* WF = (const bf16*)(ws + WS_FGW) + (size_t)e * 32 * 1024;
#pragma unroll
      for (int i = 0; i < 8; ++i) { const int c = tid + 512 * i, row = c >> 7, ch = c & 127; *(LAS u32x4*)(wst + row * 2064 + ch * 16) = *(const u32x4*)(WF + row * 1024 + ch * 8); } }
    const int c = opaque_bx(), b = c >> 4, chunk = c & 15, tok0 = b * SEQ + chunk * 128;
    const int tb = wave & 3, kh = wave >> 2;
    bf16x8 xf[32];
    { const bf16* xp = (const bf16*)(ws + WS_XB) + (size_t)(tok0 + 32 * tb) * DMODEL + 512 * kh; const unsigned xl = (unsigned)(r32 * 1024 + 8 * hi);
#pragma unroll
      for (int ks = 0; ks < 32; ++ks) xf[ks] = *(const bf16x8*)(xp + 16 * ks + xl); }
    __syncthreads();
    f32x16 acc;
#pragma unroll
    for (int r = 0; r < 16; ++r) acc[r] = 0.f;
    { LAS const unsigned char* wp = wst + r32 * 2064 + (512 * kh + 8 * hi) * 2;
#pragma unroll
      for (int ks = 0; ks < 32; ++ks) acc = __builtin_amdgcn_mfma_f32_32x32x16_bf16(*(const LAS bf16x8*)(wp + ks * 32), xf[ks], acc, 0, 0, 0); }
    if (kh == 1) part[tb * 64 + lane] = (f32x4){acc[0], acc[1], acc[2], acc[3]};
    __syncthreads();
    if (kh == 0) {
        const f32x4 pv = part[tb * 64 + lane];
        const int tl = 32 * tb + r32;
        const float* sq = (const float*)(ws + WS_SSQA) + (size_t)(tok0 + tl) * 16;
        const f32x4 q0 = *(const f32x4*)(sq), q1 = *(const f32x4*)(sq + 4), q2 = *(const f32x4*)(sq + 8), q3 = *(const f32x4*)(sq + 12);
        const float ssum = ((q0[0] + q0[1]) + (q0[2] + q0[3])) + ((q1[0] + q1[1]) + (q1[2] + q1[3])) + ((q2[0] + q2[1]) + (q2[2] + q2[3])) + ((q3[0] + q3[1]) + (q3[2] + q3[3]));
        const float rstd = rsqrtf(ssum * (1.0f / 1024.0f) + RMS_EPS);
        const f32x4 fb = *(const f32x4*)(P->fox_b + e * 8 + 4 * hi);
        f32x4 o;
#pragma unroll
        for (int j = 0; j < 4; ++j) { const float z = (acc[j] + pv[j]) * rstd + fb[j];
            o[j] = fminf(z, 0.f) - 0.6931471805599453f * __builtin_amdgcn_logf(1.0f + __builtin_amdgcn_exp2f(-fabsf(z) * LOG2E)); }
        *(LAS f32x4*)(lf + tl * 8 + 4 * hi) = o;
    }
    __syncthreads();
    {
        const int h = wave; const float a = lf[(2 * lane) * 8 + h], b2 = lf[(2 * lane + 1) * 8 + h]; const float s2 = a + b2; float inc = s2;
#pragma unroll
        for (int o = 1; o < 64; o <<= 1) { const float t = shup(inc, lane, o); if (lane >= o) inc += t; }
        const float exc = inc - s2;
        float* cl = (float*)(P->ws + WS_CL) + (size_t)(b * 8 + h) * SEQ + chunk * 128;
        *(float2*)(cl + 2 * lane) = make_float2(exc + a, exc + s2);
        if (lane == 63) ((float*)(P->ws + WS_TOT))[(b * 8 + h) * 16 + chunk] = inc;
    }
    __syncthreads();
}

namespace att {
constexpr int OFF_TAB = 139264, OFF_PRE = OFF_TAB + 1280, OFF_MISC = OFF_PRE + 64, ATT_LDS = OFF_MISC + 64;
__device__ __forceinline__ int crow(int r, int hi) { return (r & 3) + 8 * (r >> 2) + 4 * hi; }
__device__ __forceinline__ bf16x8 lds16(LAS const unsigned char* p) { return *(const LAS bf16x8*)p; }
__device__ __forceinline__ bf16x8 vfrag(LAS const unsigned char* p) {
    const v4i16_t lo = __builtin_amdgcn_ds_read_tr16_b64_v4i16((LAS v4i16_t*)p), hi = __builtin_amdgcn_ds_read_tr16_b64_v4i16((LAS v4i16_t*)(p + 512));
    return (bf16x8){lo[0], lo[1], lo[2], lo[3], hi[0], hi[1], hi[2], hi[3]};
}
__device__ __forceinline__ float xlane_partner(float v) {
    const unsigned u = __builtin_bit_cast(unsigned, v); auto rr = __builtin_amdgcn_permlane32_swap(u, u, false, false);
    return __builtin_bit_cast(float, rr[0] ^ rr[1] ^ u);
}
enum { MODE_SB = 0, MODE_FOX = 1, MODE_DIFF = 2 };

template <int MODE, int NDG>
__device__ __forceinline__ void tile_compute(f32x16 (&o)[4], f32x16& negm, float& m, float& thr, float& l, float& R, const bf16x8 (&qr)[4], LAS const unsigned char* ast, LAS const unsigned char* kst, LAS const unsigned char* vst,
                                             int k0, int qw0, int r32, int hi, int lane, LAS const float* dtab) {
    f32x16 p0, p1;
    LAS const unsigned char* kp = kst + r32 * 144 + hi * 16;
    {   f32x16 z;
#pragma unroll
        for (int r = 0; r < 16; ++r) z[r] = 0.f;
        const bf16x8 a0 = lds16(kp), a1 = lds16(kp + 32 * 144);
        p0 = __builtin_amdgcn_mfma_f32_32x32x16_bf16(a0, qr[0], MODE == MODE_SB ? z : negm, 0, 0, 0);
        p1 = __builtin_amdgcn_mfma_f32_32x32x16_bf16(a1, qr[0], MODE == MODE_SB ? z : negm, 0, 0, 0); }
#pragma unroll
    for (int d0 = 1; d0 < 4; ++d0) {
        const bf16x8 a0 = lds16(kp + d0 * 32), a1 = lds16(kp + 32 * 144 + d0 * 32);
        p0 = __builtin_amdgcn_mfma_f32_32x32x16_bf16(a0, qr[d0], p0, 0, 0, 0);
        p1 = __builtin_amdgcn_mfma_f32_32x32x16_bf16(a1, qr[d0], p1, 0, 0, 0);
    }
#ifdef PROBE_XMFMA
    if (MODE == MODE_DIFF) { f32x16 d0_ = p0, d1_ = p1;
#pragma unroll
        for (int d0 = 0; d0 < 4; ++d0) { d0_ = __builtin_amdgcn_mfma_f32_32x32x16_bf16(qr[d0], qr[d0], d0_, 0, 0, 0); d1_ = __builtin_amdgcn_mfma_f32_32x32x16_bf16(qr[d0], qr[d0], d1_, 0, 0, 0); }
        asm volatile("" :: "v"(d0_), "v"(d1_)); }
#endif
#ifdef PROBE_XLDS
    if (MODE == MODE_DIFF) {
#pragma unroll
        for (int d0 = 0; d0 < 4; ++d0) { const bf16x8 a0 = lds16(kp + d0 * 32 + 64 * 144), a1 = lds16(kp + 32 * 144 + d0 * 32 + 64 * 144); asm volatile("" :: "v"(a0), "v"(a1)); }
        LAS const unsigned char* vq = vst + ((lane >> 4) & 1) * 32 + (lane & 3) * 8 + (4 * hi + ((lane & 15) >> 2)) * 64;
#pragma unroll
        for (int i = 0; i < 8; ++i) { const bf16x8 vf = vfrag(vq + i * 1024); asm volatile("" :: "v"(vf)); } }
#endif
    if (MODE == MODE_FOX) {
        const bf16x8 a0 = lds16(ast + r32 * 16), a1 = lds16(ast + (32 + r32) * 16);
        const short one = hi ? (short)0 : (short)0x3F80;
        const bf16x8 qa = (bf16x8){one, one, one, 0, 0, 0, 0, 0};
        p0 = __builtin_amdgcn_mfma_f32_32x32x16_bf16(a0, qa, p0, 0, 0, 0);
        p1 = __builtin_amdgcn_mfma_f32_32x32x16_bf16(a1, qa, p1, 0, 0, 0);
    }
    if (MODE == MODE_DIFF) {
        if (k0 + 63 + 113 > qw0) {
            LAS const float* rt = dtab + (207 - (qw0 - k0 + r32 - 4 * hi));
#pragma unroll
            for (int r = 0; r < 16; ++r) { p0[r] += rt[(r & 3) + 8 * (r >> 2)]; p1[r] += rt[(r & 3) + 8 * (r >> 2) + 32]; }
        }
    } else if (k0 + 63 >= qw0) {
        const int q = qw0 + r32, kb = k0 + 4 * hi;
#pragma unroll
        for (int r = 0; r < 16; ++r) { const int kv = kb + (r & 3) + 8 * (r >> 2);
            if (MODE == MODE_SB) { if (kv >= q) p0[r] = -INFINITY; if (kv + 32 >= q) p1[r] = -INFINITY; }
            else { if (kv > q) p0[r] = -INFINITY; if (kv + 32 > q) p1[r] = -INFINITY; } }
    }
    u32x4 pw[4];
    if (MODE == MODE_SB) {
#pragma unroll
        for (int r = 0; r < 16; ++r) { p0[r] = __builtin_amdgcn_rcpf(1.0f + __builtin_amdgcn_exp2f(p0[r])); p1[r] = __builtin_amdgcn_rcpf(1.0f + __builtin_amdgcn_exp2f(p1[r])); }
        float x1[8], x0[8], GG[8], EG[8];
#pragma unroll
        for (int j = 0; j < 8; ++j) {
            const int g = j & 3; float a3, a2, a1, a0;
            if (j < 4) { a3 = p0[4 * g + 3]; a2 = p0[4 * g + 2]; a1 = p0[4 * g + 1]; a0 = p0[4 * g]; } else { a3 = p1[4 * g + 3]; a2 = p1[4 * g + 2]; a1 = p1[4 * g + 1]; a0 = p1[4 * g]; }
            x1[j] = a3 * a2; x0[j] = x1[j] * a1; const float G = x0[j] * a0;
            const float Gp = xlane_partner(G);
            GG[j] = G * Gp; EG[j] = hi ? 1.0f : Gp;
        }
        float T = R; float w[32];
#pragma unroll
        for (int j = 7; j >= 0; --j) {
            const float E = T * EG[j]; T *= GG[j];
            const int g = j & 3; float a3, a2, a1, a0;
            if (j < 4) { a3 = p0[4 * g + 3]; a2 = p0[4 * g + 2]; a1 = p0[4 * g + 1]; a0 = p0[4 * g]; } else { a3 = p1[4 * g + 3]; a2 = p1[4 * g + 2]; a1 = p1[4 * g + 1]; a0 = p1[4 * g]; }
            { const float t2 = E * a3, t1 = E * x1[j], t0 = E * x0[j];
              w[4 * j + 3] = __builtin_fmaf(-a3, E, E); w[4 * j + 2] = __builtin_fmaf(-a2, t2, t2); w[4 * j + 1] = __builtin_fmaf(-a1, t1, t1); w[4 * j] = __builtin_fmaf(-a0, t0, t0); }
        }
        R = T;
#pragma unroll
        for (int ks = 0; ks < 4; ++ks) { pw[ks].x = cvtpk(w[8 * ks], w[8 * ks + 1]); pw[ks].y = cvtpk(w[8 * ks + 2], w[8 * ks + 3]); pw[ks].z = cvtpk(w[8 * ks + 4], w[8 * ks + 5]); pw[ks].w = cvtpk(w[8 * ks + 6], w[8 * ks + 7]); }
    } else {
        float a = fmaxf(fmaxf(p0[0], p0[1]), p1[0]), b = fmaxf(fmaxf(p0[2], p0[3]), p1[1]); a = fmaxf(fmaxf(a, p1[2]), p1[3]);
#pragma unroll
        for (int r = 4; r < 16; r += 4) { a = fmaxf(fmaxf(a, p0[r]), p0[r + 1]); b = fmaxf(fmaxf(b, p0[r + 2]), p0[r + 3]); a = fmaxf(fmaxf(a, p1[r]), p1[r + 1]); b = fmaxf(fmaxf(b, p1[r + 2]), p1[r + 3]); }
        float rm = fmaxf(a, b); rm = fmaxf(rm, xlane_partner(rm));
        if (__any(rm > thr)) {
            const float d = (thr < 0.f) ? ((rm > -INFINITY) ? rm : 0.f) : fmaxf(rm, 0.f);
            m += d;
#pragma unroll
            for (int r = 0; r < 16; ++r) { p0[r] -= d; p1[r] -= d; }
            if (thr >= 0.f) { const float f = __builtin_amdgcn_exp2f(-d); l *= f;
#pragma unroll
                for (int dg = 0; dg < NDG; ++dg)
#pragma unroll
                    for (int r = 0; r < 16; ++r) o[dg][r] *= f; }
#pragma unroll
            for (int r = 0; r < 16; ++r) negm[r] = -m;
            thr = 8.0f;
        }
        float s0 = 0.f, s1 = 0.f;
#pragma unroll
        for (int r = 0; r < 16; ++r) { p0[r] = __builtin_amdgcn_exp2f(p0[r]); p1[r] = __builtin_amdgcn_exp2f(p1[r]); s0 += p0[r]; s1 += p1[r]; }
        l += s0 + s1;
        pw[0] = (u32x4){cvtpk(p0[0], p0[1]), cvtpk(p0[2], p0[3]), cvtpk(p0[4], p0[5]), cvtpk(p0[6], p0[7])};
        pw[1] = (u32x4){cvtpk(p0[8], p0[9]), cvtpk(p0[10], p0[11]), cvtpk(p0[12], p0[13]), cvtpk(p0[14], p0[15])};
        pw[2] = (u32x4){cvtpk(p1[0], p1[1]), cvtpk(p1[2], p1[3]), cvtpk(p1[4], p1[5]), cvtpk(p1[6], p1[7])};
        pw[3] = (u32x4){cvtpk(p1[8], p1[9]), cvtpk(p1[10], p1[11]), cvtpk(p1[12], p1[13]), cvtpk(p1[14], p1[15])};
    }
    LAS const unsigned char* vp = vst + ((lane >> 4) & 1) * 32 + (lane & 3) * 8 + (4 * hi + ((lane & 15) >> 2)) * 64;
#pragma unroll
    for (int ks = 0; ks < 4; ++ks)
#pragma unroll
        for (int dg = 0; dg < NDG; ++dg) {
            const bf16x8 vf = vfrag(vp + dg * 4096 + ks * 1024);
            o[dg] = __builtin_amdgcn_mfma_f32_32x32x16_bf16(vf, __builtin_bit_cast(bf16x8, pw[ks]), o[dg], 0, 0, 0);
        }
}

template <int MODE, int NDG, int VSTRIDE>
__device__ __forceinline__ void stage2_compute(f32x16 (&o)[4], f32x16& negm, float& m, float& l, const bf16x8 (&qr)[4], LAS const unsigned char* ast, LAS const unsigned char* kst, LAS const unsigned char* vst, int r32, int hi, int lane) {
    f32x16 p[4];
    LAS const unsigned char* kp = kst + r32 * 144 + hi * 16;
#pragma unroll
    for (int i = 0; i < 4; ++i) p[i] = __builtin_amdgcn_mfma_f32_32x32x16_bf16(lds16(kp + i * 32 * 144), qr[0], negm, 0, 0, 0);
#pragma unroll
    for (int d0 = 1; d0 < 4; ++d0)
#pragma unroll
        for (int i = 0; i < 4; ++i) p[i] = __builtin_amdgcn_mfma_f32_32x32x16_bf16(lds16(kp + i * 32 * 144 + d0 * 32), qr[d0], p[i], 0, 0, 0);
    if (MODE == MODE_FOX) {
        const short one = hi ? (short)0 : (short)0x3F80;
        const bf16x8 qa = (bf16x8){one, one, one, 0, 0, 0, 0, 0};
#pragma unroll
        for (int i = 0; i < 4; ++i) p[i] = __builtin_amdgcn_mfma_f32_32x32x16_bf16(lds16(ast + (32 * i + r32) * 16), qa, p[i], 0, 0, 0);
    }
    float a = fmaxf(p[0][0], p[0][1]), b = fmaxf(p[0][2], p[0][3]);
#pragma unroll
    for (int i = 0; i < 4; ++i)
#pragma unroll
        for (int r = (i == 0 ? 4 : 0); r < 16; r += 4) { a = fmaxf(fmaxf(a, p[i][r]), p[i][r + 1]); b = fmaxf(fmaxf(b, p[i][r + 2]), p[i][r + 3]); }
    float rm = fmaxf(a, b); rm = fmaxf(rm, xlane_partner(rm));
    if (__any(rm > 8.0f)) {
        const float d = fmaxf(rm, 0.f), f = __builtin_amdgcn_exp2f(-d); m += d; l *= f;
#pragma unroll
        for (int i = 0; i < 4; ++i)
#pragma unroll
            for (int r = 0; r < 16; ++r) p[i][r] -= d;
#pragma unroll
        for (int dg = 0; dg < NDG; ++dg)
#pragma unroll
            for (int r = 0; r < 16; ++r) o[dg][r] *= f;
#pragma unroll
        for (int r = 0; r < 16; ++r) negm[r] = -m;
    }
    float s0 = 0.f, s1 = 0.f;
#pragma unroll
    for (int i = 0; i < 4; ++i)
#pragma unroll
        for (int r = 0; r < 16; r += 2) { p[i][r] = __builtin_amdgcn_exp2f(p[i][r]); p[i][r + 1] = __builtin_amdgcn_exp2f(p[i][r + 1]); s0 += p[i][r]; s1 += p[i][r + 1]; }
    l += s0 + s1;
    LAS const unsigned char* vp = vst + ((lane >> 4) & 1) * 32 + (lane & 3) * 8 + (4 * hi + ((lane & 15) >> 2)) * 64;
#pragma unroll
    for (int i = 0; i < 4; ++i)
#pragma unroll
        for (int j = 0; j < 2; ++j) {
            const u32x4 pw = (u32x4){cvtpk(p[i][8 * j], p[i][8 * j + 1]), cvtpk(p[i][8 * j + 2], p[i][8 * j + 3]), cvtpk(p[i][8 * j + 4], p[i][8 * j + 5]), cvtpk(p[i][8 * j + 6], p[i][8 * j + 7])};
#pragma unroll
            for (int dg = 0; dg < NDG; ++dg) {
                const bf16x8 vf = vfrag(vp + (i >> 1) * VSTRIDE + dg * 4096 + ((i & 1) * 2 + j) * 1024);
                o[dg] = __builtin_amdgcn_mfma_f32_32x32x16_bf16(vf, __builtin_bit_cast(bf16x8, pw), o[dg], 0, 0, 0);
            }
        }
}

__device__ __forceinline__ void store_o(bf16* op, const f32x16& o, float f) {
#pragma unroll
    for (int g = 0; g < 4; ++g) { u32x2 w; w.x = cvtpk(o[4 * g] * f, o[4 * g + 1] * f); w.y = cvtpk(o[4 * g + 2] * f, o[4 * g + 3] * f); *(u32x2*)(op + 8 * g) = w; }
}

__device__ __forceinline__ void fox_phase(LAS unsigned char* lds, int L) {
    constexpr int FK = 0, FV = 18432, FA = FV + 16384, FST = FA + 2048;
    const KP P = kparams(); const int tid = opaque_tid(), lane = tid & 63, wave = __builtin_amdgcn_readfirstlane(tid >> 6);
    const int r32 = lane & 31, hi = lane >> 5;
    const int bx = opaque_bx(), vcu = (bx & 7) * 32 + (bx >> 3), xcd = vcu >> 5, grp = (vcu & 31) >> 2, mi = vcu & 3;
    unsigned char* ws = P->ws;
    const bf16* Qb = (const bf16*)(ws + WS_Q); const bf16* Kb = (const bf16*)(ws + WS_K); const bf16* Vb = (const bf16*)(ws + WS_V); bf16* Ob = (bf16*)(ws + WS_O);
    LAS float* pre = (LAS float*)(lds + OFF_PRE);
    const int kvs = tid >> 3, ch = tid & 7;
    const int klds = FK + kvs * 144 + ch * 16;
    const int vkey0 = 64 * ((2 * wave) >> 3) + 16 * ((2 * wave) & 3) + (lane >> 2), vcol0 = 32 * (((2 * wave) >> 2) & 1) + 8 * (lane & 3);
    const int vlds = FV + ((2 * wave) >> 3) * 8192 + (((2 * wave) >> 2) & 1) * 4096 + ((2 * wave) & 3) * 1024 + 16 * lane;
    for (int ui = 0; ui < 4; ++ui) {
        const int bh = xcd * 16 + (ui >> 1) * 8 + grp, b = bh >> 3, hj = bh & 7, qblk = (ui & 1) ? mi : 7 - mi;
        const int col = 512 + 64 * hj;
        const size_t tokb = (size_t)b * SEQ;
        const float* clp = (const float*)(ws + WS_CL) + (size_t)(b * 8 + hj) * SEQ;
        if (!(ui & 1)) {
            if (wave == 0) { float v = (lane < 16) ? ((const float*)(ws + WS_TOT))[(b * 8 + hj) * 16 + lane] : 0.f; float inc = v;
#pragma unroll
                for (int o = 1; o < 16; o <<= 1) { const float t = shup(inc, lane, o); if (lane >= o) inc += t; }
                if (lane < 16) pre[lane] = inc - v; }
            __syncthreads();
        }
        const int q0 = 256 * qblk, NT = 2 * qblk + 2, qw0 = q0 + 32 * wave, th = (qw0 + 31) >> 6;
        bf16x8 qr[4];
        { const bf16* qp = Qb + (tokb + qw0 + r32) * 1024 + col + 8 * hi;
#pragma unroll
          for (int d0 = 0; d0 < 4; ++d0) qr[d0] = *(const bf16x8*)(qp + 16 * d0); }
        f32x16 o[4];
#pragma unroll
        for (int dg = 0; dg < 4; ++dg)
#pragma unroll
            for (int r = 0; r < 16; ++r) o[dg][r] = 0.f;
        float m = 0.f, thr = -INFINITY, l = 0.f, R = 1.0f; f32x16 negm;
#pragma unroll
        for (int r = 0; r < 16; ++r) negm[r] = 0.f;
        u32x4 kreg[2], vreg[2]; float creg = 0.f;
#define FOX_LOAD(T) do { const bf16* kg = Kb + (tokb + 128 * (T) + kvs) * 1024 + col + 8 * ch; const bf16* vg = Vb + (tokb + 128 * (T) + vkey0) * 1024 + col + vcol0; \
        kreg[0] = *(const u32x4*)(kg); kreg[1] = *(const u32x4*)(kg + 64 * 1024); vreg[0] = *(const u32x4*)(vg); vreg[1] = *(const u32x4*)(vg + 16 * 1024); \
        if (tid < 128) creg = clp[128 * (T) + tid] + pre[(T)]; } while (0)
#define FOX_STORE(sb) do { LAS unsigned char* s_ = lds + (sb) * FST; \
        *(LAS u32x4*)(s_ + klds) = kreg[0]; *(LAS u32x4*)(s_ + klds + 64 * 144) = kreg[1]; *(LAS u32x4*)(s_ + vlds) = vreg[0]; *(LAS u32x4*)(s_ + vlds + 1024) = vreg[1]; \
        if (tid < 128) { const float v_ = -creg * LOG2E; const unsigned h_ = f2bf(v_); const float r1_ = v_ - bf2f(h_); const unsigned l_ = f2bf(r1_); const float r2_ = r1_ - bf2f(l_); const unsigned l2_ = f2bf(r2_); \
            *(LAS u32x4*)(s_ + FA + tid * 16) = (u32x4){h_ | (l_ << 16), l2_, 0u, 0u}; } } while (0)
        FOX_LOAD(NT - 1); FOX_STORE(0);
        __syncthreads();
        asm volatile("" :: "v"(qr[0]), "v"(qr[1]), "v"(qr[2]), "v"(qr[3]));
        for (int it = 0; it < NT; ++it) {
            const int T = NT - 1 - it;
            if (it + 1 < NT) FOX_LOAD(T - 1);
            LAS const unsigned char* st = lds + (it & 1) * FST;
            if (2 * T + 1 <= th) tile_compute<MODE_FOX, 2>(o, negm, m, thr, l, R, qr, st + FA + 64 * 16, st + FK + 64 * 144, st + FV + 8192, 128 * T + 64, qw0, r32, hi, lane, nullptr);
            if (2 * T <= th) tile_compute<MODE_FOX, 2>(o, negm, m, thr, l, R, qr, st + FA, st + FK, st + FV, 128 * T, qw0, r32, hi, lane, nullptr);
            if (it + 1 < NT) FOX_STORE((it + 1) & 1);
            __syncthreads();
        }
#undef FOX_LOAD
#undef FOX_STORE
        const float lt = l + xlane_partner(l), f = 1.0f / lt;
        bf16* op = Ob + (tokb + qw0 + r32) * 1024 + col + 4 * hi;
        store_o(op, o[0], f); store_o(op + 32, o[1], f);
    }
}

__device__ __forceinline__ void sb_phase(LAS unsigned char* lds, int L) {
    const KP P = kparams(); const int tid = opaque_tid(), lane = tid & 63, wave = __builtin_amdgcn_readfirstlane(tid >> 6);
    const int r32 = lane & 31, hi = lane >> 5;
    const int bx = opaque_bx(), vcu = (bx & 7) * 32 + (bx >> 3), gw = vcu * 8 + wave;
    unsigned char* ws = P->ws;
    const bf16* Qb = (const bf16*)(ws + WS_Q); const bf16* Kb = (const bf16*)(ws + WS_K); const bf16* Vb = (const bf16*)(ws + WS_V); bf16* Ob = (bf16*)(ws + WS_O);
    LAS unsigned char* wl = lds + wave * 17408;
    const int kv0 = lane >> 3, ch = lane & 7;
    const unsigned klane = (unsigned)(kv0 * 1024 + 8 * ch), vlane = (unsigned)((lane >> 2) * 1024 + 8 * (lane & 3));
    const int klds = kv0 * 144 + ch * 16;
    const int vlds = 9216 + 16 * lane;
    for (int i = 0; i < 4; ++i) {
        const int id = i * 2048 + gw, bj = id >> 6, rb = id & 63, b = bj >> 3, j = bj & 7;
        const size_t tokb = (size_t)b * SEQ; const int qw0 = 32 * rb, th = (qw0 + 31) >> 6, col = 64 * j;
        bf16x8 qr[4];
        { const bf16* qp = Qb + (tokb + qw0) * 1024 + col; const unsigned ql = (unsigned)(r32 * 1024 + 8 * hi);
#pragma unroll
          for (int d0 = 0; d0 < 4; ++d0) qr[d0] = *(const bf16x8*)(qp + 16 * d0 + ql); }
        f32x16 o[4];
#pragma unroll
        for (int dg = 0; dg < 4; ++dg)
#pragma unroll
            for (int r = 0; r < 16; ++r) o[dg][r] = 0.f;
        float m = 0.f, thr = -INFINITY, l = 0.f, R = 1.0f; f32x16 negm;
#pragma unroll
        for (int r = 0; r < 16; ++r) negm[r] = 0.f;
        u32x4 kreg[8], vreg[8];
#define SB_LOAD(t) do { const bf16* kg = Kb + (tokb + 64 * (t)) * 1024 + col; const bf16* vg = Vb + (tokb + 64 * (t)) * 1024 + col; unsigned ko_ = klane, vo_ = vlane; \
        _Pragma("unroll") for (int c_ = 0; c_ < 8; ++c_) { kreg[c_] = *(const u32x4*)(kg + ko_); ko_ += 8 * 1024; asm volatile("" : "+v"(ko_)); }     \
        _Pragma("unroll") for (int c_ = 0; c_ < 8; ++c_) { vreg[c_] = *(const u32x4*)(vg + vo_); vo_ += (c_ == 3) ? 32 - 3 * 16 * 1024 : 16 * 1024; asm volatile("" : "+v"(vo_)); } } while (0)
#define SB_STORE() do { _Pragma("unroll") for (int c_ = 0; c_ < 8; ++c_) { *(LAS u32x4*)(wl + klds + c_ * 8 * 144) = kreg[c_]; *(LAS u32x4*)(wl + vlds + c_ * 1024) = vreg[c_]; } } while (0)
        SB_LOAD(th); SB_STORE();
        asm volatile("" :: "v"(qr[0]), "v"(qr[1]), "v"(qr[2]), "v"(qr[3]));
        for (int t = th; t >= 0; --t) {
            if (t > 0) SB_LOAD(t - 1);
            tile_compute<MODE_SB, 2>(o, negm, m, thr, l, R, qr, nullptr, wl, wl + 9216, 64 * t, qw0, r32, hi, lane, nullptr);
            if (!__any(R >= 1.17549435e-38f)) break;
            if (t > 0) SB_STORE();
        }
#undef SB_LOAD
#undef SB_STORE
        bf16* op = Ob + (tokb + qw0) * 1024 + col + (unsigned)(r32 * 1024 + 4 * hi);
        store_o(op, o[0], 1.0f); store_o(op + 32, o[1], 1.0f);
    }
}

__device__ __forceinline__ void diff_phase(LAS unsigned char* lds, int L) {
    constexpr int DKS = 18432, DVO = 2 * DKS, DST = DVO + 32768;
    const KP P = kparams(); const int tid = opaque_tid(), lane = tid & 63, wave = __builtin_amdgcn_readfirstlane(tid >> 6);
    const int r32 = lane & 31, hi = lane >> 5, map = wave >> 2, wq = wave & 3;
    const int bx = opaque_bx(), vcu = (bx & 7) * 32 + (bx >> 3), xcd = vcu >> 5, grp = (vcu & 31) >> 3, mi = vcu & 7, eo = L >> 1;
    unsigned char* ws = P->ws;
    const bf16* Qb = (const bf16*)(ws + WS_Q); const bf16* Kb = (const bf16*)(ws + WS_K); const bf16* Vb = (const bf16*)(ws + WS_V); bf16* Ob = (bf16*)(ws + WS_O);
    LAS float* dtab = (LAS float*)(lds + OFF_TAB);
    const float lam_init = 0.8f - 0.6f * __builtin_amdgcn_exp2f(-0.3f * LOG2E * (float)L);
    const float s1 = wave_sum(P->lq1[eo * 64 + lane] * P->lk1[eo * 64 + lane]), s2 = wave_sum(P->lq2[eo * 64 + lane] * P->lk2[eo * 64 + lane]);
    const float lam = __builtin_amdgcn_exp2f(s1 * LOG2E) - __builtin_amdgcn_exp2f(s2 * LOG2E) + lam_init;
    const int ksub = wave >> 2, krow0 = 32 * (wave & 3) + (lane >> 3);
    const int klds = ksub * DKS + krow0 * 144 + (lane & 7) * 16;
    const int vtile = wave >> 2, vdg = wave & 3, vkey0 = 64 * vtile + (lane >> 2);
    const int vlds = DVO + vtile * 16384 + vdg * 4096 + 16 * lane;
    for (int ui = 0; ui < 8; ++ui) {
        const int bh = xcd * 16 + (ui >> 1) * 4 + grp, b = bh >> 3, hj = bh & 7, qblk = (ui & 1) ? mi : 15 - mi;
        const size_t tokb = (size_t)b * SEQ;
        const int kgcol = 128 * hj + 64 * ksub + 8 * (lane & 7), vgcol = 128 * hj + 32 * vdg + 8 * (lane & 3);
        if (!(ui & 1)) {
            if (tid < 320) { const int d = 207 - tid; float v = 0.f;
                if (d < 0) v = -INFINITY;
                else if (d < 128) { int bk = d;
                    if (d >= 16) { bk = 16 + (int)(__builtin_amdgcn_logf((float)d * 0.0625f) * (16.0f / 3.0f)); bk = bk > 31 ? 31 : bk; }
                    v = (P->rel_bias[bk * 8 + hj] - P->rel_bias[31 * 8 + hj]) * LOG2E; }
                dtab[tid] = v; }
            __syncthreads();
        }
        const int q0 = 128 * qblk, NT = qblk + 1, qw0 = q0 + 32 * wq, th = (qw0 + 31) >> 6;
        bf16x8 qr[4];
        { const bf16* qp = Qb + (tokb + qw0 + r32) * 1024 + 128 * hj + 64 * map + 8 * hi;
#pragma unroll
          for (int d0 = 0; d0 < 4; ++d0) qr[d0] = *(const bf16x8*)(qp + 16 * d0); }
        f32x16 o[4];
#pragma unroll
        for (int dg = 0; dg < 4; ++dg)
#pragma unroll
            for (int r = 0; r < 16; ++r) o[dg][r] = 0.f;
        float m = 0.f, thr = -INFINITY, l = 0.f, R = 1.0f; f32x16 negm;
#pragma unroll
        for (int r = 0; r < 16; ++r) negm[r] = 0.f;
        u32x4 kreg[4], vreg[4];
#define DF_LOAD(T) do { const bf16* kg = Kb + (tokb + 128 * (T) + krow0) * 1024 + kgcol; const bf16* vg = Vb + (tokb + 128 * (T) + vkey0) * 1024 + vgcol; \
        _Pragma("unroll") for (int c_ = 0; c_ < 4; ++c_) { kreg[c_] = *(const u32x4*)(kg + c_ * 8 * 1024); vreg[c_] = *(const u32x4*)(vg + c_ * 16 * 1024); } } while (0)
#define DF_STORE(sb) do { LAS unsigned char* s_ = lds + (sb) * DST; \
        _Pragma("unroll") for (int c_ = 0; c_ < 4; ++c_) { *(LAS u32x4*)(s_ + klds + c_ * 8 * 144) = kreg[c_]; *(LAS u32x4*)(s_ + vlds + c_ * 1024) = vreg[c_]; } } while (0)
        DF_LOAD(NT - 1); DF_STORE(0);
        __syncthreads();
        asm volatile("" :: "v"(qr[0]), "v"(qr[1]), "v"(qr[2]), "v"(qr[3]));
        for (int it = 0; it < NT; ++it) {
            const int T = NT - 1 - it;
            if (it + 1 < NT) DF_LOAD(T - 1);
            LAS const unsigned char* st = lds + (it & 1) * DST; LAS const unsigned char* kst = st + map * DKS;
            if (2 * T + 1 <= th) tile_compute<MODE_DIFF, 4>(o, negm, m, thr, l, R, qr, nullptr, kst + 64 * 144, st + DVO + 16384, 128 * T + 64, qw0, r32, hi, lane, dtab);
            if (2 * T <= th) tile_compute<MODE_DIFF, 4>(o, negm, m, thr, l, R, qr, nullptr, kst, st + DVO, 128 * T, qw0, r32, hi, lane, dtab);
            if (it + 1 < NT) DF_STORE((it + 1) & 1);
            __syncthreads();
        }
#undef DF_LOAD
#undef DF_STORE
        const float lt = l + xlane_partner(l); const float f = (map ? lam : 1.0f) / lt;
        LAS float* X = (LAS float*)(lds + wq * 16384);
        if (map == 1) {
#pragma unroll
            for (int dg = 0; dg < 4; ++dg)
#pragma unroll
                for (int r = 0; r < 16; ++r) X[(dg * 16 + r) * 64 + lane] = o[dg][r] * f;
        }
        __syncthreads();
        if (map == 0) {
            float ss = 0.f;
#pragma unroll
            for (int dg = 0; dg < 4; ++dg)
#pragma unroll
                for (int r = 0; r < 16; ++r) { const float d = o[dg][r] * f - X[(dg * 16 + r) * 64 + lane]; o[dg][r] = d; ss += d * d; }
            ss += xlane_partner(ss);
            const float rn = rsqrtf(ss * (1.0f / 128.0f) + RMS_EPS) * (1.0f - lam_init);
            const float* sg = P->subln_g + eo * 128 + 4 * hi;
            bf16* orow = Ob + (tokb + qw0 + r32) * 1024 + 128 * hj + 4 * hi;
            f32x4 gv[16];
#pragma unroll
            for (int i = 0; i < 16; ++i) gv[i] = *(const f32x4*)(sg + 32 * (i >> 2) + 8 * (i & 3));
#pragma unroll
            for (int dg = 0; dg < 4; ++dg)
#pragma unroll
                for (int g = 0; g < 4; ++g) { const f32x4 gg = gv[4 * dg + g];
                    u32x2 w; w.x = cvtpk(o[dg][4 * g] * rn * gg[0], o[dg][4 * g + 1] * rn * gg[1]); w.y = cvtpk(o[dg][4 * g + 2] * rn * gg[2], o[dg][4 * g + 3] * rn * gg[3]);
                    *(u32x2*)(orow + 32 * dg + 8 * g) = w; }
        }
        __syncthreads();
    }
}
}
#define XB_TMO      128
#define XB_XCNT(j)  (256  + 64 * (j))
#define XB_XSUB(j)  (1280 + 64 * (j))
#define XB_XGEN(j)  (2304 + 64 * (j))
#define XB_TOP      3328
#define XB_TOPGEN   3392
#define XCD_BAR_WORDS 3456
#define XB_SPIN_CAP (1u << 18)

__device__ __forceinline__ unsigned xb_ld(unsigned* p)              { return __hip_atomic_load(p, __ATOMIC_RELAXED, __HIP_MEMORY_SCOPE_AGENT); }
__device__ __forceinline__ unsigned xb_add(unsigned* p, unsigned v) { return __hip_atomic_fetch_add(p, v, __ATOMIC_RELAXED, __HIP_MEMORY_SCOPE_AGENT); }
__device__ __forceinline__ unsigned xb_xcc_id() { return (unsigned)__builtin_amdgcn_s_getreg((3 << 11) | 20) & 0xFu; }
#define XB_SPIN(cond, bar) do { unsigned _sp = 0; while (cond) { __builtin_amdgcn_s_sleep(1); \
    if ((++_sp & 255u) == 0u) { if (xb_ld(&(bar)[XB_TMO])) break; if (_sp > XB_SPIN_CAP) { atomicAdd(&(bar)[XB_TMO], 1u); break; } } } } while (0)

struct XcdBarrier {
    unsigned* bar; unsigned x;
    volatile LAS unsigned* st;
};

__device__ __forceinline__ XcdBarrier xcd_barrier_post(unsigned* bar, volatile LAS unsigned* st) {
    XcdBarrier b; b.bar = bar; b.x = xb_xcc_id(); b.st = st;
    if (threadIdx.x == 0) (void)xb_add(&bar[XB_XCNT(b.x)], 1u);
    return b;
}
__device__ __forceinline__ void xcd_barrier_complete(unsigned* bar, unsigned x, unsigned& nloc, unsigned& nx) {
    const unsigned G = gridDim.x * gridDim.y * gridDim.z;
    unsigned sum, cnt, mine, sp = 0u;
    for (;;) {
        sum = 0u; cnt = 0u; mine = 0u;
#pragma unroll
        for (unsigned j = 0; j < 16; ++j) { const unsigned c = xb_ld(&bar[XB_XCNT(j)]); sum += c; cnt += (c > 0u) ? 1u : 0u; mine = (j == x) ? c : mine; }
        if (sum == G) break;
        __builtin_amdgcn_s_sleep(1);
        if ((++sp & 255u) == 0u) { if (xb_ld(&bar[XB_TMO])) break; if (sp > XB_SPIN_CAP) { atomicAdd(&bar[XB_TMO], 1u); break; } }
    }
    nloc = mine > 0u ? mine : 1u; nx = cnt > 0u ? cnt : 1u;
}

__device__ __forceinline__ void xcd_barrier(const XcdBarrier& b) {
    asm volatile("s_waitcnt vmcnt(0)" ::: "memory");
    __syncthreads();
    if (threadIdx.x == 0) {
        unsigned* bar = b.bar; unsigned bx_ = b.x;
        asm volatile("" : "+s"(bar), "+s"(bx_));
        __builtin_amdgcn_s_waitcnt(0);
        unsigned nloc = b.st[0], nx = b.st[1];
        if (nloc == 0u) { xcd_barrier_complete(bar, bx_, nloc, nx); b.st[0] = nloc; b.st[1] = nx; }
        const unsigned old = xb_add(&bar[XB_XSUB(bx_)], 1u);
        const unsigned gen = old / nloc;
        if (old + 1u == (gen + 1u) * nloc) {
            __builtin_amdgcn_fence(__ATOMIC_RELEASE, "agent");
            asm volatile("s_waitcnt vmcnt(0)" ::: "memory");
            const unsigned og = xb_add(&bar[XB_TOP], 1u);
            const unsigned tg = og / nx;
            if (og + 1u == (tg + 1u) * nx) xb_add(&bar[XB_TOPGEN], 1u);
            else XB_SPIN(xb_ld(&bar[XB_TOPGEN]) == tg, bar);
            __builtin_amdgcn_fence(__ATOMIC_ACQUIRE, "agent");
            xb_add(&bar[XB_XGEN(bx_)], 1u);
            asm volatile("s_waitcnt vmcnt(0)" ::: "memory");
        } else {
            XB_SPIN(xb_ld(&bar[XB_XGEN(bx_)]) == gen, bar);
            __builtin_amdgcn_fence(__ATOMIC_ACQUIRE, "agent");
            asm volatile("s_waitcnt vmcnt(0)" ::: "memory");
        }
    }
    __syncthreads();
}

constexpr int LDS_BYTES = att::ATT_LDS;
__global__ void __launch_bounds__(512, 2) fwd_kernel(Params P) {
    extern __shared__ __attribute__((aligned(16))) unsigned char lds_raw[];
    LAS unsigned char* lds = (LAS unsigned char*)lds_raw;
    cg::grid_group grid = cg::this_grid();
    unsigned* barw = (unsigned*)(kparams()->ws + WS_BAR);
    { const int t0 = opaque_tid(); if (blockIdx.x == 0) for (int i = t0; i < XCD_BAR_WORDS; i += 512) barw[i] = 0u;
      if (t0 < 16) ((LAS unsigned*)(lds + att::OFF_MISC))[t0] = 0u; }
#ifndef SKIP_P0
    p0_prologue(lds);
#endif
#ifdef PROBE_P02
    __syncthreads(); p0_prologue(lds);
#endif
    grid.sync();
    const XcdBarrier xbar = xcd_barrier_post(barw, (volatile LAS unsigned*)(lds + att::OFF_MISC));
#pragma unroll 1
    for (int L = 0; L < DEPTH; ++L) {
        const int odd = L & 1, eo = L >> 1;
#ifndef SKIP_FG
        if (!odd) fg_phase(lds, L);
#endif
#ifdef PROBE_FG2
        if (!odd) fg_phase(lds, L);
#endif
        {
            const KP P = kparams(); unsigned char* ws = P->ws;
            pg8::Gemm g{(const bf16*)(ws + WS_XB), (const bf16*)(ws + WS_W + (size_t)L * W_LAYER + W_IN), MTOK, 3072, 1024}; pg8::StaticOrder S; S.init(MTOK, 3072, 256, opaque_bx());
            pg8::EpiQKV E{(bf16*)(ws + WS_Q), (const float*)(ws + WS_SSQA), (odd ? P->diff_gq : P->fox_gq) + eo * 64, (odd ? P->diff_gk : P->fox_gk) + eo * 64, odd};
#ifndef SKIP_G1
            pg8::gemm_phase<pg8::EpiQKV, pg8::StaticOrder, PG8_ALIGN, PG8_SP2>(lds, g, S, E);
#endif
#ifdef PROBE_QKV2
            pg8::gemm_phase<pg8::EpiQKV, pg8::StaticOrder, PG8_ALIGN, PG8_SP2>(lds, g, S, E);
#endif
        }
        xcd_barrier(xbar);
#ifdef PROBE_PRIO
        if (opaque_tid() >= 256) __builtin_amdgcn_s_setprio(1);
#endif
#ifndef SKIP_DIFF
        if (odd) att::diff_phase(lds, L);
#endif
#ifdef PROBE_DIFF2
        if (odd) { __syncthreads(); att::diff_phase(lds, L); }
#endif
#ifdef PROBE_FOX2
        if (!odd) { att::fox_phase(lds, L); __syncthreads(); }
#endif
#ifdef PROBE_SB2
        if (!odd) { att::sb_phase(lds, L); __syncthreads(); }
#endif
#ifdef PROBE_EVEN2
        if (!odd) { att::fox_phase(lds, L); att::sb_phase(lds, L); __syncthreads(); }
#endif
#ifndef SKIP_FOX
        if (!odd) att::fox_phase(lds, L);
#endif
#ifndef SKIP_SB
        if (!odd) att::sb_phase(lds, L);
#endif
#ifdef PROBE_PRIO
        __builtin_amdgcn_s_setprio(0);
#endif
        xcd_barrier(xbar);
        {
            const KP P = kparams(); unsigned char* ws = P->ws;
            pg8::Gemm g{(const bf16*)(ws + WS_O), (const bf16*)(ws + WS_W + (size_t)L * W_LAYER + W_O), MTOK, 1024, 1024}; pg8::StaticOrder S; S.init(MTOK, 1024, 256, opaque_bx());
            pg8::EpiResid E{(bf16*)(ws + WS_XB), P->out, (float*)(ws + WS_SSQF), 0};
#ifndef SKIP_G2
            pg8::gemm_phase<pg8::EpiResid, pg8::StaticOrder, PG8_ALIGN, PG8_SP2>(lds, g, S, E);
#endif
        }
        xcd_barrier(xbar);
        {
            const KP P = kparams(); unsigned char* ws = P->ws;
            pg8::Gemm g{(const bf16*)(ws + WS_XB), (const bf16*)(ws + WS_W + (size_t)L * W_LAYER + W_GU), MTOK, 2 * DFF, 1024}; pg8::StaticOrder S; S.init(MTOK, 2 * DFF, 256, opaque_bx());
            pg8::EpiSwiGLU E{(bf16*)(ws + WS_H), (const float*)(ws + WS_SSQF)};
#ifndef SKIP_G3
            pg8::gemm_phase<pg8::EpiSwiGLU, pg8::StaticOrder, PG8_ALIGN, PG8_SP2>(lds, g, S, E);
#endif
#ifdef PROBE_GU2
            pg8::gemm_phase<pg8::EpiSwiGLU, pg8::StaticOrder, PG8_ALIGN, PG8_SP2>(lds, g, S, E);
#endif
        }
        xcd_barrier(xbar);
        {
            const KP P = kparams(); unsigned char* ws = P->ws;
            pg8::Gemm g{(const bf16*)(ws + WS_H), (const bf16*)(ws + WS_W + (size_t)L * W_LAYER + W_D), MTOK, 1024, DFF}; pg8::StaticOrder S; S.init(MTOK, 1024, 256, opaque_bx());
            pg8::EpiResid E{(bf16*)(ws + WS_XB), P->out, (float*)(ws + WS_SSQA), L == DEPTH - 1};
#ifndef SKIP_G4
            pg8::gemm_phase<pg8::EpiResid, pg8::StaticOrder, PG8_ALIGN, PG8_SP2>(lds, g, S, E);
#endif
        }
        if (L + 1 < DEPTH) xcd_barrier(xbar);
#ifdef PROBE_BAR2
        for (int rep = 0; rep < 5; ++rep) xcd_barrier(xbar);
#endif
    }
}

extern "C" void kernel_launch(void* const* d_in, const int* in_sizes, int n_in, void* d_out, int out_size, void* d_ws, size_t ws_size, hipStream_t stream) {
    static int grid = 0;
    if (grid == 0) {
        if (n_in != 21 || in_sizes[0] != MTOK * DMODEL || out_size != MTOK * DMODEL || ws_size < WS_END) { fprintf(stderr, "kernel_launch: unexpected shapes (n_in %d, in0 %d, out %d, ws %zu)\n", n_in, n_in > 0 ? in_sizes[0] : -1, out_size, ws_size); grid = -1; return; }
        int dev = 0, cus = 0, per_cu = 0;
        hipGetDevice(&dev); hipDeviceGetAttribute(&cus, hipDeviceAttributeMultiprocessorCount, dev);
        if (hipFuncSetAttribute((const void*)fwd_kernel, hipFuncAttributeMaxDynamicSharedMemorySize, LDS_BYTES) != hipSuccess) { fprintf(stderr, "kernel_launch: hipFuncSetAttribute failed\n"); grid = -1; return; }
        hipOccupancyMaxActiveBlocksPerMultiprocessor(&per_cu, (const void*)fwd_kernel, 512, LDS_BYTES);
        if (cus * per_cu < 256) { fprintf(stderr, "kernel_launch: device holds only %d x %d resident workgroups, need 256\n", cus, per_cu); grid = -1; return; }
        grid = 256;
    }
    if (grid < 0) return;
    Params p{};
    const float** f = (const float**)&p;
    for (int i = 0; i < 21; ++i) f[i] = (const float*)d_in[i];
    p.out = (float*)d_out; p.ws = (unsigned char*)d_ws;
    void* args[] = {&p};
    hipError_t e = hipLaunchCooperativeKernel((const void*)fwd_kernel, dim3(grid), dim3(512), args, LDS_BYTES, stream);
    if (e != hipSuccess) fprintf(stderr, "cooperative launch failed: %s\n", hipGetErrorString(e));
}
```

```cpp
#include <hip/hip_runtime.h>
#include <hip/hip_cooperative_groups.h>
#include <cstdio>
#include <cstdint>
namespace cg = cooperative_groups;
__device__ __forceinline__ float xor32f(float v) { const unsigned u = __builtin_bit_cast(unsigned, v); auto rr = __builtin_amdgcn_permlane32_swap(u, u, false, false); return __builtin_bit_cast(float, rr[0] ^ rr[1] ^ u); }
template <int MASK> __device__ __forceinline__ float shx(float v) {
    if (MASK == 32) return xor32f(v);
    return __builtin_bit_cast(float, __builtin_amdgcn_ds_swizzle(__builtin_bit_cast(int, v), (MASK << 10) | 0x1f));
}
__device__ __forceinline__ float shup(float v, int lane, int o) { return __builtin_bit_cast(float, __builtin_amdgcn_ds_bpermute(((lane - o) & 63) << 2, __builtin_bit_cast(int, v))); }
__device__ __forceinline__ int opaque_tid() { int t = (int)threadIdx.x; asm volatile("" : "+v"(t)); return t; }

namespace pg8 {
#define PG8_LAS __attribute__((address_space(3)))
typedef unsigned short bf16_t;
typedef short bf16x8 __attribute__((ext_vector_type(8)));
typedef float f32x4 __attribute__((ext_vector_type(4)));
typedef unsigned u32x4 __attribute__((ext_vector_type(4)));
constexpr int BM = 256, BK = 64, HALF = 128, HTB = HALF * BK * 2  , STAGE_BYTES = 8 * HTB, NXCD = 8, WGM = 8;

__host__ __device__ __forceinline__ int lds_byte(int r, int c) { const int st = (r >> 4) * 2 + (c >> 5), rr = r & 15, cc = c & 31, ob = rr * 64 + cc * 2; return st * 1024 + (ob ^ (((ob >> 9) & 1) << 5)); }
__host__ __device__ __forceinline__ void stage_rc(int b, int& R, int& C) { const int st = b / 1024, sb = b % 1024, swz = sb ^ (((sb >> 9) & 1) << 5); R = (st >> 1) * 16 + swz / 64; C = (st & 1) * 32 + (swz % 64) / 2; }
__host__ __device__ __forceinline__ int perm32(int rho) { const int n = rho >> 4, i = rho & 15; return 8 * (i >> 2) + 4 * n + (i & 3); }

struct Unit { int pm, pn; };
struct Gemm { const bf16_t* A; const bf16_t* Bt; int M, N, K; };

struct StaticOrder {
    int nM, nN, nwg, G, c;
    __host__ __device__ void init(int M, int N, int G_, int c_) { nM = M / BM; nN = N / BM; nwg = nM * nN; G = G_; c = c_; }
    __host__ __device__ bool next(int i, Unit& u) const {
        const long L = (long)i * G + c; if (L >= nwg) return false;
        int wgid = (int)L; { const int q = nwg / NXCD, r = nwg % NXCD, xcd = wgid % NXCD, off = wgid / NXCD; wgid = (xcd < r ? xcd * (q + 1) : r * (q + 1) + (xcd - r) * q) + off; }
        const int nig = WGM * nN, gid = wgid / nig, fm = gid * WGM, gsz = (nM - fm) < WGM ? (nM - fm) : WGM;
        u.pm = fm + ((wgid % nig) % gsz); u.pn = (wgid % nig) / gsz; return true;
    }
    __device__ __forceinline__ void a_ready(const Unit&) const {}
    __device__ __forceinline__ void done(const Unit&) const {}
};

typedef float f32x2 __attribute__((ext_vector_type(2)));
typedef __bf16 bf16x2_t __attribute__((ext_vector_type(2)));
typedef unsigned u32x2 __attribute__((ext_vector_type(2)));
__device__ __forceinline__ unsigned cvtpk(float lo, float hi) { f32x2 v = {lo, hi}; bf16x2_t b = __builtin_convertvector(v, bf16x2_t); return __builtin_bit_cast(unsigned, b); }
constexpr float RMS_EPS_F = 1e-6f;
constexpr float LOG2E_F = 1.4426950408889634f;
constexpr float C2_F = 0.125f * LOG2E_F;
__device__ __forceinline__ void load_rstd(const float* ssq, int row0, int fq, float (&rs)[2][4]) {
#pragma unroll
    for (int ai = 0; ai < 2; ++ai)
#pragma unroll
        for (int m = 0; m < 4; ++m) {
            const f32x4 v = *(const f32x4*)(ssq + (size_t)(row0 + ai * HALF + m * 16) * 16 + 4 * fq);
            float s = (v[0] + v[1]) + (v[2] + v[3]);
            s += shx<16>(s); s += shx<32>(s);
            rs[ai][m] = rsqrtf(s * (1.0f / 1024.0f) + RMS_EPS_F);
        }
}
struct EpiQKV {
    static constexpr bool PERM = true, AFTER_DRAIN = false;
    bf16_t* Q; const float* ssq; const float* gq; const float* gk; int odd;
    __device__ __forceinline__ void operator()(const f32x4 (&acc)[2][2][4][2], const Unit& u, int wr, int wc, int fr, int fq) const {
        const int buf = u.pn >> 2, pl = u.pn & 3;
        const int row0 = u.pm * BM + wr * 64 + fr;
        const int colbase = 256 * pl + 64 * wc + 8 * fq;
        bf16_t* base = Q + (size_t)buf * (size_t)(32u << 20);
        const bool norm = (buf < 2) && (odd || pl >= 2);
        const float sc = (buf == 0) ? C2_F : 1.0f;
        const float* g = gq + ((buf == 0) ? 0 : (gk - gq));
        const f32x4 one4 = (f32x4){1.f, 1.f, 1.f, 1.f};
        const float* gp = g + 8 * fq;
        const f32x4 g00 = (norm ? *(const f32x4*)(gp) : one4) * sc, g01 = (norm ? *(const f32x4*)(gp + 4) : one4) * sc;
        const f32x4 g10 = (norm ? *(const f32x4*)(gp + 32) : one4) * sc, g11 = (norm ? *(const f32x4*)(gp + 36) : one4) * sc;
        float rs[2][4]; load_rstd(ssq, row0, fq, rs);
#pragma unroll
        for (int ai = 0; ai < 2; ++ai)
#pragma unroll
            for (int m = 0; m < 4; ++m) {
                float mul = rs[ai][m];
                if (norm) {
                    float ss = 0.f;
#pragma unroll
                    for (int bj = 0; bj < 2; ++bj)
#pragma unroll
                        for (int n = 0; n < 2; ++n) { const f32x4 x = acc[ai][bj][m][n]; ss += (x[0] * x[0] + x[1] * x[1]) + (x[2] * x[2] + x[3] * x[3]); }
                    ss += shx<16>(ss); ss += shx<32>(ss);
                    mul *= rsqrtf(ss * mul * mul * (1.0f / 64.0f) + RMS_EPS_F);
                }
                bf16_t* rowp = base + (size_t)(row0 + ai * HALF + m * 16) * 1024 + colbase;
                {   const f32x4 v0 = acc[ai][0][m][0] * mul * g00, v1 = acc[ai][0][m][1] * mul * g01;
                    u32x4 w; w.x = cvtpk(v0[0], v0[1]); w.y = cvtpk(v0[2], v0[3]); w.z = cvtpk(v1[0], v1[1]); w.w = cvtpk(v1[2], v1[3]);
                    *(u32x4*)(rowp) = w; }
                {   const f32x4 v0 = acc[ai][1][m][0] * mul * g10, v1 = acc[ai][1][m][1] * mul * g11;
                    u32x4 w; w.x = cvtpk(v0[0], v0[1]); w.y = cvtpk(v0[2], v0[3]); w.z = cvtpk(v1[0], v1[1]); w.w = cvtpk(v1[2], v1[3]);
                    *(u32x4*)(rowp + 32) = w; }
            }
    }
};
struct EpiSwiGLU {
    static constexpr bool PERM = true, AFTER_DRAIN = false;
    bf16_t* H; const float* ssq;
    __device__ __forceinline__ void operator()(const f32x4 (&acc)[2][2][4][2], const Unit& u, int wr, int wc, int fr, int fq) const {
        const int row0 = u.pm * BM + wr * 64 + fr;
        const int col0 = 128 * u.pn + 32 * wc + 8 * fq;
        float rs[2][4]; load_rstd(ssq, row0, fq, rs);
#pragma unroll
        for (int ai = 0; ai < 2; ++ai)
#pragma unroll
            for (int m = 0; m < 4; ++m) {
                const float mul = rs[ai][m];
                float hv[8];
#pragma unroll
                for (int n = 0; n < 2; ++n)
#pragma unroll
                    for (int i = 0; i < 4; ++i) {
                        const float a = acc[ai][0][m][n][i] * mul, up = acc[ai][1][m][n][i] * mul;
                        const float e = __builtin_amdgcn_exp2f(-a * LOG2E_F);
                        hv[4 * n + i] = a * up * __builtin_amdgcn_rcpf(1.0f + e);
                    }
                u32x4 w; w.x = cvtpk(hv[0], hv[1]); w.y = cvtpk(hv[2], hv[3]); w.z = cvtpk(hv[4], hv[5]); w.w = cvtpk(hv[6], hv[7]);
                *(u32x4*)(H + (size_t)(row0 + ai * HALF + m * 16) * 2816 + col0) = w;
            }
    }
};
struct EpiResid {
    static constexpr bool PERM = true, AFTER_DRAIN = false;
    bf16_t* xb; float* out; float* ssq_out; int last;
    __device__ __forceinline__ void operator()(const f32x4 (&acc)[2][2][4][2], const Unit& u, int wr, int wc, int fr, int fq) const {
        const int row0 = u.pm * BM + wr * 64 + fr;
        const int col0 = u.pn * BM + wc * 32 + 8 * fq;
        u32x4 w[2][4][2];
#pragma unroll
        for (int ai = 0; ai < 2; ++ai)
#pragma unroll
            for (int m = 0; m < 4; ++m)
#pragma unroll
                for (int bj = 0; bj < 2; ++bj) w[ai][m][bj] = *(const u32x4*)(xb + (size_t)(row0 + ai * HALF + m * 16) * 1024 + col0 + bj * HALF);
#pragma unroll
        for (int ai = 0; ai < 2; ++ai)
#pragma unroll
            for (int m = 0; m < 4; ++m) {
                const int row = row0 + ai * HALF + m * 16;
                const size_t off = (size_t)row * 1024 + col0;
                float ss = 0.f;
#pragma unroll
                for (int bj = 0; bj < 2; ++bj) {
                    const u32x4 wv = w[ai][m][bj];
                    f32x4 o0 = acc[ai][bj][m][0], o1 = acc[ai][bj][m][1];
                    o0[0] += __builtin_bit_cast(float, wv.x << 16); o0[1] += __builtin_bit_cast(float, wv.x & 0xffff0000u); o0[2] += __builtin_bit_cast(float, wv.y << 16); o0[3] += __builtin_bit_cast(float, wv.y & 0xffff0000u);
                    o1[0] += __builtin_bit_cast(float, wv.z << 16); o1[1] += __builtin_bit_cast(float, wv.z & 0xffff0000u); o1[2] += __builtin_bit_cast(float, wv.w << 16); o1[3] += __builtin_bit_cast(float, wv.w & 0xffff0000u);
                    if (last) { *(f32x4*)(out + off + bj * HALF) = o0; *(f32x4*)(out + off + bj * HALF + 4) = o1; }
                    else {
                        u32x4 v; v.x = cvtpk(o0[0], o0[1]); v.y = cvtpk(o0[2], o0[3]); v.z = cvtpk(o1[0], o1[1]); v.w = cvtpk(o1[2], o1[3]);
                        *(u32x4*)(xb + off + bj * HALF) = v;
                        ss += (o0[0] * o0[0] + o0[1] * o0[1]) + (o0[2] * o0[2] + o0[3] * o0[3]) + (o1[0] * o1[0] + o1[1] * o1[1]) + (o1[2] * o1[2] + o1[3] * o1[3]);
                    }
                }
                if (!last) {
                    ss += __shfl_xor(ss, 16); ss += __shfl_xor(ss, 32);
                    if (fq == 0) ssq_out[(size_t)row * 16 + 4 * u.pn + wc] = ss;
                }
            }
    }
};
template <class Epi, class Sched, bool ALIGN_EPI = false, bool SP2 = false>
__device__ __forceinline__ void gemm_phase(PG8_LAS unsigned char* lds, const Gemm g, const Sched& S, const Epi& E) {
    const int tid = opaque_tid(), wid = __builtin_amdgcn_readfirstlane(tid >> 6), lane = tid & 63, wr = wid >> 2, wc = wid & 3, fr = lane & 15, fq = lane >> 4;
    const int K = g.K, nt = K / BK;
    unsigned voffA[2], voffB[2];
#pragma unroll
    for (int i = 0; i < 2; ++i) { int R, C; stage_rc(tid * 16 + i * 8192, R, C); const int Rb = Epi::PERM ? ((R & ~31) + perm32(R & 31)) : R;
        voffA[i] = (unsigned)(R * K + C) * 2u; voffB[i] = (unsigned)(Rb * K + C) * 2u; }
    const size_t kstep = (size_t)(BK * 2);
    const size_t hstep = (size_t)HALF * K * 2;
    const size_t tstep = 2 * hstep;
    const unsigned ldsw = (unsigned)wid * 1024u;
    const int aoff = lds_byte(wr * 64 + fr, fq * 8), boff = lds_byte(wc * 32 + fr, fq * 8);
#define PG8_SA(b, h) (((b) * 2 + (h)) * HTB)
#define PG8_SB(b, h) ((4 + (b) * 2 + (h)) * HTB)
#define PG8_STAGE(bufoff, gbase, voff) do { _Pragma("unroll") for (int _i = 0; _i < 2; ++_i) \
        __builtin_amdgcn_global_load_lds((const unsigned*)((const char*)(gbase) + (voff)[_i]), (PG8_LAS unsigned*)(lds + (bufoff) + ldsw + _i * 8192), 16, 0, 0); } while (0)
#define PG8_LDA(dst, b, h) do { _Pragma("unroll") for (int m = 0; m < 4; ++m) _Pragma("unroll") for (int k = 0; k < 2; ++k) dst[m][k] = *(const PG8_LAS bf16x8*)(lds + PG8_SA(b, h) + aoff + m * 2048 + k * 1024); } while (0)
#define PG8_LDB(dst, b, h) do { _Pragma("unroll") for (int n = 0; n < 2; ++n) _Pragma("unroll") for (int k = 0; k < 2; ++k) dst[n][k] = *(const PG8_LAS bf16x8*)(lds + PG8_SB(b, h) + boff + n * 2048 + k * 1024); } while (0)
#define PG8_MMA(ai, bj, At, Bt) do { __builtin_amdgcn_s_setprio(1); _Pragma("unroll") for (int m = 0; m < 4; ++m) _Pragma("unroll") for (int n = 0; n < 2; ++n) _Pragma("unroll") for (int k = 0; k < 2; ++k) \
        acc[ai][bj][m][n] = __builtin_amdgcn_mfma_f32_16x16x32_bf16(Bt[n][k], At[m][k], acc[ai][bj][m][n], 0, 0, 0); __builtin_amdgcn_s_setprio(0); } while (0)
#define PG8_WAIT_V(n) asm volatile("s_waitcnt vmcnt(" #n ")" ::: "memory")
#define PG8_WAIT_L(n) asm volatile("s_waitcnt lgkmcnt(" #n ")" ::: "memory")
#define PG8_BAR __builtin_amdgcn_s_barrier()
#define PG8_SCHED __builtin_amdgcn_sched_barrier(0)
    Unit cur, nxt; int ui = 0;
    if (!S.next(0, cur)) return;
    f32x4 acc[2][2][4][2];
#pragma unroll
    for (int a = 0; a < 2; ++a)
#pragma unroll
        for (int b = 0; b < 2; ++b)
#pragma unroll
            for (int m = 0; m < 4; ++m)
#pragma unroll
                for (int n = 0; n < 2; ++n) acc[a][b][m][n] = (f32x4){0.f, 0.f, 0.f, 0.f};
    bf16x8 At[4][2], B0[2][2], B1[2][2];
    const char* cA = (const char*)g.A + (size_t)cur.pm * tstep; const char* cB = (const char*)g.Bt + (size_t)cur.pn * tstep;
    S.a_ready(cur);
    if constexpr (SP2) {
        PG8_STAGE(PG8_SB(0, 0), cB, voffB); PG8_STAGE(PG8_SB(0, 1), cB + hstep, voffB); PG8_STAGE(PG8_SA(0, 0), cA, voffA); PG8_STAGE(PG8_SA(0, 1), cA + hstep, voffA);
        if (wr == 1) PG8_BAR;
        PG8_WAIT_V(2); PG8_BAR;
        PG8_STAGE(PG8_SB(1, 0), cB + kstep, voffB); PG8_STAGE(PG8_SA(1, 0), cA + kstep, voffA); PG8_STAGE(PG8_SB(1, 1), cB + hstep + kstep, voffB);
        PG8_WAIT_V(6); PG8_BAR;
    } else {
        PG8_STAGE(PG8_SB(0, 0), cB, voffB); PG8_STAGE(PG8_SA(0, 0), cA, voffA); PG8_STAGE(PG8_SB(0, 1), cB + hstep, voffB); PG8_STAGE(PG8_SA(0, 1), cA + hstep, voffA);
        if (wr == 1) PG8_BAR;
        PG8_WAIT_V(4); PG8_BAR;
        PG8_STAGE(PG8_SB(1, 0), cB + kstep, voffB); PG8_STAGE(PG8_SA(1, 0), cA + kstep, voffA); PG8_STAGE(PG8_SB(1, 1), cB + hstep + kstep, voffB);
        PG8_WAIT_V(6); PG8_BAR;
    }
    for (;;) {
        const bool has_next = S.next(ui + 1, nxt);
        const char* nA = has_next ? (const char*)g.A + (size_t)nxt.pm * tstep : cA; const char* nB = has_next ? (const char*)g.Bt + (size_t)nxt.pn * tstep : cB;
        for (int t = 0; t < nt; t += 2) {
            const bool last = (t == nt - 2);
            const char* a1 = cA + (size_t)(t + 1) * kstep;
            const char* a2 = last ? nA : cA + (size_t)(t + 2) * kstep; const char* b2 = last ? nB : cB + (size_t)(t + 2) * kstep;
            const char* a3 = a2 + kstep; const char* b3 = b2 + kstep;
            if (last && has_next) S.a_ready(nxt);
            if constexpr (SP2) {
            PG8_LDB(B0, 0, 0); PG8_LDB(B1, 0, 1); PG8_SCHED; PG8_LDA(At, 0, 0); PG8_STAGE(PG8_SA(1, 1), a1 + hstep, voffA);
            PG8_WAIT_V(8); PG8_WAIT_L(0); PG8_BAR; PG8_MMA(0, 0, At, B0); PG8_MMA(0, 1, At, B1); PG8_BAR; PG8_SCHED;
            PG8_LDA(At, 0, 1); PG8_STAGE(PG8_SB(0, 0), b2, voffB); PG8_STAGE(PG8_SB(0, 1), b2 + hstep, voffB); PG8_STAGE(PG8_SA(0, 0), a2, voffA);
            PG8_WAIT_V(8); PG8_WAIT_L(0); PG8_BAR; PG8_MMA(1, 0, At, B0); PG8_MMA(1, 1, At, B1); PG8_BAR; PG8_SCHED;
            PG8_LDB(B0, 1, 0); PG8_LDB(B1, 1, 1); PG8_SCHED; PG8_LDA(At, 1, 0); PG8_STAGE(PG8_SA(0, 1), a2 + hstep, voffA);
            PG8_WAIT_V(8); PG8_WAIT_L(0); PG8_BAR; PG8_MMA(0, 0, At, B0); PG8_MMA(0, 1, At, B1); PG8_BAR; PG8_SCHED;
            PG8_LDA(At, 1, 1); PG8_STAGE(PG8_SB(1, 0), b3, voffB); PG8_STAGE(PG8_SB(1, 1), b3 + hstep, voffB); PG8_STAGE(PG8_SA(1, 0), a3, voffA);
            PG8_WAIT_V(8); PG8_WAIT_L(0); PG8_BAR; PG8_MMA(1, 0, At, B0); PG8_MMA(1, 1, At, B1); PG8_BAR; PG8_SCHED;
            } else {
            PG8_LDB(B0, 0, 0); PG8_SCHED; PG8_LDA(At, 0, 0); PG8_STAGE(PG8_SA(1, 1), a1 + hstep, voffA);
            PG8_WAIT_L(8); PG8_BAR; PG8_WAIT_L(0); PG8_MMA(0, 0, At, B0); PG8_BAR; PG8_SCHED;
            PG8_LDB(B1, 0, 1); PG8_STAGE(PG8_SB(0, 0), b2, voffB);
            PG8_BAR; PG8_WAIT_L(0); PG8_MMA(0, 1, At, B1); PG8_BAR;
            PG8_LDA(At, 0, 1); PG8_STAGE(PG8_SA(0, 0), a2, voffA);
            PG8_BAR; PG8_WAIT_L(0); PG8_MMA(1, 0, At, B0); PG8_BAR; PG8_SCHED;
            PG8_STAGE(PG8_SB(0, 1), b2 + hstep, voffB);
            PG8_WAIT_V(6); PG8_BAR; PG8_MMA(1, 1, At, B1); PG8_BAR;
            PG8_LDB(B0, 1, 0); PG8_SCHED; PG8_LDA(At, 1, 0); PG8_STAGE(PG8_SA(0, 1), a2 + hstep, voffA);
            PG8_WAIT_L(8); PG8_BAR; PG8_WAIT_L(0); PG8_MMA(0, 0, At, B0); PG8_BAR; PG8_SCHED;
            PG8_LDB(B1, 1, 1); PG8_STAGE(PG8_SB(1, 0), b3, voffB);
            PG8_BAR; PG8_WAIT_L(0); PG8_MMA(0, 1, At, B1); PG8_BAR;
            PG8_LDA(At, 1, 1); PG8_STAGE(PG8_SA(1, 0), a3, voffA);
            PG8_BAR; PG8_WAIT_L(0); PG8_MMA(1, 0, At, B0); PG8_BAR; PG8_SCHED;
            PG8_STAGE(PG8_SB(1, 1), b3 + hstep, voffB);
            PG8_WAIT_V(6); PG8_BAR; PG8_MMA(1, 1, At, B1); PG8_BAR;
            }
        }
        if constexpr (ALIGN_EPI) { if (wr == 0) PG8_BAR; }
        if constexpr (!Epi::AFTER_DRAIN) { E(acc, cur, wr, wc, fr, fq); S.done(cur); }
        if (!has_next) break;
#pragma unroll
        for (int a = 0; a < 2; ++a)
#pragma unroll
            for (int b = 0; b < 2; ++b)
#pragma unroll
                for (int m = 0; m < 4; ++m)
#pragma unroll
                    for (int n = 0; n < 2; ++n) acc[a][b][m][n] = (f32x4){0.f, 0.f, 0.f, 0.f};
        cur = nxt; cA = nA; cB = nB; ++ui;
        if constexpr (ALIGN_EPI) { if (wr == 1) PG8_BAR; }
    }
    PG8_WAIT_V(0);
    if constexpr (!ALIGN_EPI) { if (wr == 0) PG8_BAR; }
    PG8_BAR;
    if constexpr (Epi::AFTER_DRAIN) { E.fused(acc, cur, wr, wc, fr, fq, lds, wid, lane); S.done(cur); }
#undef PG8_SA
#undef PG8_SB
#undef PG8_STAGE
#undef PG8_LDA
#undef PG8_LDB
#undef PG8_MMA
#undef PG8_WAIT_V
#undef PG8_WAIT_L
#undef PG8_BAR
#undef PG8_SCHED
}
}
#ifndef PG8_SP2
#define PG8_SP2 true
#endif
#ifndef PG8_ALIGN
#define PG8_ALIGN true
#endif

constexpr int BATCH = 16, SEQ = 2048, DMODEL = 1024, DEPTH = 4, DFF = 2816, MTOK = BATCH * SEQ;
constexpr int EVEN_IN = 3080, DIFF_IN = 3072;
constexpr float RMS_EPS = 1e-6f, LOG2E = 1.4426950408889634f, C2 = 0.125f * LOG2E;
#define LAS __attribute__((address_space(3)))
typedef unsigned short bf16;
typedef short bf16x8 __attribute__((ext_vector_type(8)));
typedef float f32x4 __attribute__((ext_vector_type(4)));
typedef float f32x16 __attribute__((ext_vector_type(16)));
typedef unsigned u32x4 __attribute__((ext_vector_type(4)));
typedef unsigned u32x2 __attribute__((ext_vector_type(2)));
typedef short v4i16_t __attribute__((ext_vector_type(4)));
using pg8::cvtpk;

constexpr size_t MiB = 1u << 20;
constexpr size_t WS_W = 0, W_LAYER = 25 * MiB, W_IN = 0, W_O = 6 * MiB, W_GU = 8 * MiB, W_D = 19 * MiB;
constexpr size_t WS_XB = 100 * MiB;
constexpr size_t WS_Q = 164 * MiB, WS_K = 228 * MiB, WS_V = 292 * MiB, WS_O = 356 * MiB;
constexpr size_t WS_H = 164 * MiB;
constexpr size_t WS_SSQA = 420 * MiB, WS_SSQF = 422 * MiB;
constexpr size_t WS_CL = 424 * MiB, WS_TOT = 425 * MiB;
constexpr size_t WS_BAR = 426 * MiB;
constexpr size_t WS_FGW = 427 * MiB;
constexpr size_t WS_END = 428 * MiB;
static_assert(WS_K - WS_Q == 64 * MiB && WS_V - WS_K == 64 * MiB, "EpiQKV strides");
static_assert(WS_H + (size_t)MTOK * DFF * 2 <= WS_O, "hidden overlay");

struct Params {
    const float* x; const float* attn_g; const float* ffn_g; const float* even_w_in; const float* fox_b; const float* fox_gq; const float* fox_gk; const float* even_w_out;
    const float* diff_w_in; const float* diff_gq; const float* diff_gk; const float* lq1; const float* lk1; const float* lq2; const float* lk2; const float* subln_g; const float* diff_w_out;
    const float* rel_bias; const float* w_gate; const float* w_up; const float* w_down;
    float* out; unsigned char* ws;
};

typedef const __attribute__((address_space(4))) Params* KP;
__device__ __forceinline__ int opaque_bx() { int b = (int)blockIdx.x; asm volatile("" : "+s"(b)); return b; }
__device__ __forceinline__ KP kparams() { KP p = (KP)__builtin_amdgcn_kernarg_segment_ptr(); asm volatile("" : "+s"(p)); return p; }
template <int CTRL> __device__ __forceinline__ float dppf(float v) { return __builtin_bit_cast(float, __builtin_amdgcn_update_dpp(0, __builtin_bit_cast(int, v), CTRL, 0xF, 0xF, true)); }
__device__ __forceinline__ float wave_sum(float v) {
    v += dppf<0xB1>(v);
    v += dppf<0x4E>(v);
    v += dppf<0x141>(v);
    v += dppf<0x140>(v);
    v += shx<16>(v); v += shx<32>(v);
    return v;
}
__device__ __forceinline__ unsigned f2bf(float f) { unsigned u = __builtin_bit_cast(unsigned, f); return (u + 0x7fffu + ((u >> 16) & 1u)) >> 16; }
__device__ __forceinline__ float bf2f(unsigned b) { return __builtin_bit_cast(float, b << 16); }

struct TrItem { const float* W; const float* g; bf16* WT; int ldw, src, K, dst, k0; };
__device__ __forceinline__ TrItem tr_decode(KP P, int it) {
    constexpr int I_IN = 16 * 96, I_O = 16 * 32, I_GU = 16 * 176, I_D = 44 * 32, I_LAYER = I_IN + I_O + I_GU + I_D;
    const int L = it / I_LAYER; int r = it % I_LAYER; const int eo = L >> 1, odd = L & 1;
    unsigned char* wl = P->ws + WS_W + (size_t)L * W_LAYER;
    TrItem d;
    if (r < I_IN) {
        const int kb = r / 96, nb = r % 96, pn = nb >> 3, q8 = nb & 7, bj = q8 >> 2, wc = q8 & 3, buf = pn >> 2;
        const int c = 256 * (pn & 3) + 64 * wc + 32 * bj;
        if (odd) { d.src = buf * 1024 + c; d.W = P->diff_w_in + (size_t)eo * DMODEL * DIFF_IN; d.ldw = DIFF_IN; }
        else { d.src = (c < 512 ? 0 : 1536) + buf * 512 + (c & 511); d.W = P->even_w_in + (size_t)eo * DMODEL * EVEN_IN; d.ldw = EVEN_IN; }
        d.g = P->attn_g + L * DMODEL; d.WT = (bf16*)(wl + W_IN); d.K = 1024; d.dst = 32 * nb; d.k0 = 64 * kb; return d;
    }
    r -= I_IN;
    if (r < I_O) {
        const int kb = r / 32, nb = r % 32;
        d.W = (odd ? P->diff_w_out : P->even_w_out) + (size_t)eo * 1024 * 1024; d.ldw = 1024; d.src = 32 * nb; d.g = nullptr; d.WT = (bf16*)(wl + W_O); d.K = 1024; d.dst = 32 * nb; d.k0 = 64 * kb; return d;
    }
    r -= I_O;
    if (r < I_GU) {
        const int kb = r / 176, nb = r % 176, pn = nb >> 3, q8 = nb & 7, bj = q8 >> 2, wc = q8 & 3;
        d.W = (bj ? P->w_up : P->w_gate) + (size_t)L * DMODEL * DFF; d.ldw = DFF; d.src = 128 * pn + 32 * wc; d.g = P->ffn_g + L * DMODEL; d.WT = (bf16*)(wl + W_GU); d.K = 1024; d.dst = 32 * nb; d.k0 = 64 * kb; return d;
    }
    r -= I_GU;
    { const int kb = r / 32, nb = r % 32;
      d.W = P->w_down + (size_t)L * DFF * DMODEL; d.ldw = 1024; d.src = 32 * nb; d.g = nullptr; d.WT = (bf16*)(wl + W_D); d.K = DFF; d.dst = 32 * nb; d.k0 = 64 * kb; return d; }
}
__device__ __forceinline__ void tr_load(const TrItem& d, float (&v)[32], f32x4& g0, f32x4& g1, int lane) {
    const float* wp = d.W + (size_t)(d.k0 + (lane >> 5)) * d.ldw + d.src + (lane & 31);
#pragma unroll
    for (int i = 0; i < 32; ++i) v[i] = wp[(size_t)(2 * i) * d.ldw];
    g0 = (f32x4){1.f, 1.f, 1.f, 1.f}; g1 = g0;
    if (d.g) { const float* gp = d.g + d.k0 + 8 * (lane & 7); g0 = *(const f32x4*)gp; g1 = *(const f32x4*)(gp + 4); }
}
__device__ __forceinline__ void tr_finish(const TrItem& d, const float (&v)[32], const f32x4 g0, const f32x4 g1, LAS float* scr, int lane) {
#pragma unroll
    for (int i = 0; i < 32; ++i) scr[(2 * i + (lane >> 5)) * 33 + (lane & 31)] = v[i];
    asm volatile("s_waitcnt lgkmcnt(0)" ::: "memory");
    const int c = lane & 7;
#pragma unroll
    for (int j = 0; j < 4; ++j) { const int n = (lane >> 3) + 8 * j; const LAS float* s = scr + (8 * c) * 33 + n;
        u32x4 o; o.x = cvtpk(s[0 * 33] * g0[0], s[1 * 33] * g0[1]); o.y = cvtpk(s[2 * 33] * g0[2], s[3 * 33] * g0[3]); o.z = cvtpk(s[4 * 33] * g1[0], s[5 * 33] * g1[1]); o.w = cvtpk(s[6 * 33] * g1[2], s[7 * 33] * g1[3]);
        *(u32x4*)(d.WT + (size_t)(d.dst + n) * d.K + d.k0 + 8 * c) = o; }
    asm volatile("s_waitcnt lgkmcnt(0)" ::: "memory");
}
__device__ __forceinline__ void p0_prologue(LAS unsigned char* lds) {
    const KP P = kparams(); const int tid = opaque_tid(), lane = tid & 63, wave = __builtin_amdgcn_readfirstlane(tid >> 6);
    LAS float* scr = (LAS float*)(lds + wave * 16384);
    const int gw = opaque_bx() * 8 + wave, NGW = 256 * 8;
    constexpr int NITEMS = DEPTH * (16 * 96 + 16 * 32 + 16 * 176 + 44 * 32);
    {   TrItem cur = tr_decode(P, gw); float v[32]; f32x4 g0, g1;
        tr_load(cur, v, g0, g1, lane);
#pragma unroll 1
        for (int it = gw; it < NITEMS; it += NGW) {
            const bool hn = it + NGW < NITEMS;
            TrItem nxt = cur; float vn[32]; f32x4 h0 = g0, h1 = g1;
#pragma unroll
            for (int i = 0; i < 32; ++i) vn[i] = 0.f;
            if (hn) { nxt = tr_decode(P, it + NGW); tr_load(nxt, vn, h0, h1, lane); }
            tr_finish(cur, v, g0, g1, scr, lane);
            cur = nxt; g0 = h0; g1 = h1;
#pragma unroll
            for (int i = 0; i < 32; ++i) v[i] = vn[i];
        }
    }
    for (int idx = gw * 64 + lane; idx < 2 * 32 * 1024; idx += NGW * 64) { const int e = idx >> 15, n = (idx >> 10) & 31, k = idx & 1023;
        const float v = n < 8 ? P->even_w_in[(size_t)e * DMODEL * EVEN_IN + (size_t)k * EVEN_IN + 3072 + n] * P->attn_g[2 * e * DMODEL + k] : 0.f;
        ((bf16*)(P->ws + WS_FGW))[idx] = (bf16)(cvtpk(v, 0.f) & 0xffffu); }
    bf16* XB = (bf16*)(P->ws + WS_XB); float* ssq = (float*)(P->ws + WS_SSQA);
    for (int m0 = gw; m0 < MTOK; m0 += 2 * NGW) {
        f32x4 v[2][4];
#pragma unroll
        for (int rr = 0; rr < 2; ++rr) { const f32x4* xr = (const f32x4*)(P->x + (size_t)(m0 + rr * NGW) * DMODEL) + lane;
#pragma unroll
            for (int j = 0; j < 4; ++j) v[rr][j] = xr[64 * j]; }
#pragma unroll
        for (int rr = 0; rr < 2; ++rr) { const int m = m0 + rr * NGW; float s = 0.f;
            unsigned long long* o8 = (unsigned long long*)(XB + (size_t)m * DMODEL) + lane;
#pragma unroll
            for (int j = 0; j < 4; ++j) { const f32x4 x = v[rr][j]; s += (x[0] * x[0] + x[1] * x[1]) + (x[2] * x[2] + x[3] * x[3]);
                o8[64 * j] = (unsigned long long)cvtpk(x[0], x[1]) | ((unsigned long long)cvtpk(x[2], x[3]) << 32); }
            s = wave_sum(s);
            if (lane < 16) ssq[(size_t)m * 16 + lane] = (lane == 0) ? s : 0.f; }
    }
}

__device__ __forceinline__ void fg_phase(LAS unsigned char* lds, int L) {
    const KP P = kparams(); const int tid = opaque_tid(), lane = tid & 63, wave = __builtin_amdgcn_readfirstlane(tid >> 6);
    const int e = L >> 1, r32 = lane & 31, hi = lane >> 5;
    LAS float* lf = (LAS float*)lds;
    LAS f32x4* part = (LAS f32x4*)(lds + 4096);
    LAS unsigned char* wst = lds + 8192;
    unsigned char* ws = P->ws;
    { const bf16* WF = (const bf16*)(ws + WS_FGW) + (size_t)e * 32 * 1024;
#pragma unroll
      for (int i = 0; i < 8; ++i) { const int c = tid + 512 * i, row = c >> 7, ch = c & 127; *(LAS u32x4*)(wst + row * 2064 + ch * 16) = *(const u32x4*)(WF + row * 1024 + ch * 8); } }
    const int c = opaque_bx(), b = c >> 4, chunk = c & 15, tok0 = b * SEQ + chunk * 128;
    const int tb = wave & 3, kh = wave >> 2;
    bf16x8 xf[32];
    { const bf16* xp = (const bf16*)(ws + WS_XB) + (size_t)(tok0 + 32 * tb) * DMODEL + 512 * kh; const unsigned xl = (unsigned)(r32 * 1024 + 8 * hi);
#pragma unroll
      for (int ks = 0; ks < 32; ++ks) xf[ks] = *(const bf16x8*)(xp + 16 * ks + xl); }
    __syncthreads();
    f32x16 acc;
#pragma unroll
    for (int r = 0; r < 16; ++r) acc[r] = 0.f;
    { LAS const unsigned char* wp = wst + r32 * 2064 + (512 * kh + 8 * hi) * 2;
#pragma unroll
      for (int ks = 0; ks < 32; ++ks) acc = __builtin_amdgcn_mfma_f32_32x32x16_bf16(*(const LAS bf16x8*)(wp + ks * 32), xf[ks], acc, 0, 0, 0); }
    if (kh == 1) part[tb * 64 + lane] = (f32x4){acc[0], acc[1], acc[2], acc[3]};
    __syncthreads();
    if (kh == 0) {
        const f32x4 pv = part[tb * 64 + lane];
        const int tl = 32 * tb + r32;
        const float* sq = (const float*)(ws + WS_SSQA) + (size_t)(tok0 + tl) * 16;
        const f32x4 q0 = *(const f32x4*)(sq), q1 = *(const f32x4*)(sq + 4), q2 = *(const f32x4*)(sq + 8), q3 = *(const f32x4*)(sq + 12);
        const float ssum = ((q0[0] + q0[1]) + (q0[2] + q0[3])) + ((q1[0] + q1[1]) + (q1[2] + q1[3])) + ((q2[0] + q2[1]) + (q2[2] + q2[3])) + ((q3[0] + q3[1]) + (q3[2] + q3[3]));
        const float rstd = rsqrtf(ssum * (1.0f / 1024.0f) + RMS_EPS);
        const f32x4 fb = *(const f32x4*)(P->fox_b + e * 8 + 4 * hi);
        f32x4 o;
#pragma unroll
        for (int j = 0; j < 4; ++j) { const float z = (acc[j] + pv[j]) * rstd + fb[j];
            o[j] = fminf(z, 0.f) - 0.6931471805599453f * __builtin_amdgcn_logf(1.0f + __builtin_amdgcn_exp2f(-fabsf(z) * LOG2E)); }
        *(LAS f32x4*)(lf + tl * 8 + 4 * hi) = o;
    }
    __syncthreads();
    {
        const int h = wave; const float a = lf[(2 * lane) * 8 + h], b2 = lf[(2 * lane + 1) * 8 + h]; const float s2 = a + b2; float inc = s2;
#pragma unroll
        for (int o = 1; o < 64; o <<= 1) { const float t = shup(inc, lane, o); if (lane >= o) inc += t; }
        const float exc = inc - s2;
        float* cl = (float*)(P->ws + WS_CL) + (size_t)(b * 8 + h) * SEQ + chunk * 128;
        *(float2*)(cl + 2 * lane) = make_float2(exc + a, exc + s2);
        if (lane == 63) ((float*)(P->ws + WS_TOT))[(b * 8 + h) * 16 + chunk] = inc;
    }
    __syncthreads();
}

namespace att {
constexpr int OFF_TAB = 139264, OFF_PRE = OFF_TAB + 1280, OFF_MISC = OFF_PRE + 64, ATT_LDS = OFF_MISC + 64;
__device__ __forceinline__ int crow(int r, int hi) { return (r & 3) + 8 * (r >> 2) + 4 * hi; }
__device__ __forceinline__ bf16x8 lds16(LAS const unsigned char* p) { return *(const LAS bf16x8*)p; }
__device__ __forceinline__ bf16x8 vfrag(LAS const unsigned char* p) {
    const v4i16_t lo = __builtin_amdgcn_ds_read_tr16_b64_v4i16((LAS v4i16_t*)p), hi = __builtin_amdgcn_ds_read_tr16_b64_v4i16((LAS v4i16_t*)(p + 512));
    return (bf16x8){lo[0], lo[1], lo[2], lo[3], hi[0], hi[1], hi[2], hi[3]};
}
__device__ __forceinline__ float xlane_partner(float v) {
    const unsigned u = __builtin_bit_cast(unsigned, v); auto rr = __builtin_amdgcn_permlane32_swap(u, u, false, false);
    return __builtin_bit_cast(float, rr[0] ^ rr[1] ^ u);
}
__device__ __forceinline__ float xlane_max(float v) { const unsigned u = __builtin_bit_cast(unsigned, v); auto rr = __builtin_amdgcn_permlane32_swap(u, u, false, false); return fmaxf(__builtin_bit_cast(float, rr[0]), __builtin_bit_cast(float, rr[1])); }
enum { MODE_SB = 0, MODE_FOX = 1, MODE_DIFF = 2 };

template <int MODE, int NDG>
__device__ __forceinline__ void tile_compute(f32x16 (&o)[4], f32x16& negm, float& m, float& thr, float& l, float& R, const bf16x8 (&qr)[4], LAS const unsigned char* ast, LAS const unsigned char* kst, LAS const unsigned char* vst,
                                             int k0, int qw0, int r32, int hi, int lane, LAS const float* dtab) {
    f32x16 p0, p1;
    LAS const unsigned char* kp = kst + r32 * 144 + hi * 16;
    {   f32x16 z;
#pragma unroll
        for (int r = 0; r < 16; ++r) z[r] = 0.f;
        const bf16x8 a0 = lds16(kp), a1 = lds16(kp + 32 * 144);
        p0 = __builtin_amdgcn_mfma_f32_32x32x16_bf16(a0, qr[0], MODE == MODE_SB ? z : negm, 0, 0, 0);
        p1 = __builtin_amdgcn_mfma_f32_32x32x16_bf16(a1, qr[0], MODE == MODE_SB ? z : negm, 0, 0, 0); }
#pragma unroll
    for (int d0 = 1; d0 < 4; ++d0) {
        const bf16x8 a0 = lds16(kp + d0 * 32), a1 = lds16(kp + 32 * 144 + d0 * 32);
        p0 = __builtin_amdgcn_mfma_f32_32x32x16_bf16(a0, qr[d0], p0, 0, 0, 0);
        p1 = __builtin_amdgcn_mfma_f32_32x32x16_bf16(a1, qr[d0], p1, 0, 0, 0);
    }
#ifdef PROBE_XMFMA
    if (MODE == MODE_DIFF) { f32x16 d0_ = p0, d1_ = p1;
#pragma unroll
        for (int d0 = 0; d0 < 4; ++d0) { d0_ = __builtin_amdgcn_mfma_f32_32x32x16_bf16(qr[d0], qr[d0], d0_, 0, 0, 0); d1_ = __builtin_amdgcn_mfma_f32_32x32x16_bf16(qr[d0], qr[d0], d1_, 0, 0, 0); }
        asm volatile("" :: "v"(d0_), "v"(d1_)); }
#endif
#ifdef PROBE_XLDS
    if (MODE == MODE_DIFF) {
#pragma unroll
        for (int d0 = 0; d0 < 4; ++d0) { const bf16x8 a0 = lds16(kp + d0 * 32 + 64 * 144), a1 = lds16(kp + 32 * 144 + d0 * 32 + 64 * 144); asm volatile("" :: "v"(a0), "v"(a1)); }
        LAS const unsigned char* vq = vst + ((lane >> 4) & 1) * 32 + (lane & 3) * 8 + (4 * hi + ((lane & 15) >> 2)) * 64;
#pragma unroll
        for (int i = 0; i < 8; ++i) { const bf16x8 vf = vfrag(vq + i * 1024); asm volatile("" :: "v"(vf)); } }
#endif
    if (MODE == MODE_FOX) {
        const bf16x8 a0 = lds16(ast + r32 * 16), a1 = lds16(ast + (32 + r32) * 16);
        const short one = hi ? (short)0 : (short)0x3F80;
        const bf16x8 qa = (bf16x8){one, one, one, 0, 0, 0, 0, 0};
        p0 = __builtin_amdgcn_mfma_f32_32x32x16_bf16(a0, qa, p0, 0, 0, 0);
        p1 = __builtin_amdgcn_mfma_f32_32x32x16_bf16(a1, qa, p1, 0, 0, 0);
    }
    if (MODE == MODE_DIFF) {
        if (k0 + 63 + 113 > qw0) {
            LAS const float* rt = dtab + (207 - (qw0 - k0 + r32 - 4 * hi));
#pragma unroll
            for (int r = 0; r < 16; ++r) { p0[r] += rt[(r & 3) + 8 * (r >> 2)]; p1[r] += rt[(r & 3) + 8 * (r >> 2) + 32]; }
        }
    } else if (k0 + 63 >= qw0) {
        const int q = qw0 + r32, kb = k0 + 4 * hi;
#pragma unroll
        for (int r = 0; r < 16; ++r) { const int kv = kb + (r & 3) + 8 * (r >> 2);
            if (MODE == MODE_SB) { if (kv >= q) p0[r] = -INFINITY; if (kv + 32 >= q) p1[r] = -INFINITY; }
            else { if (kv > q) p0[r] = -INFINITY; if (kv + 32 > q) p1[r] = -INFINITY; } }
    }
    u32x4 pw[4];
    if (MODE == MODE_SB) {
#pragma unroll
        for (int r = 0; r < 16; ++r) { p0[r] = __builtin_amdgcn_rcpf(1.0f + __builtin_amdgcn_exp2f(p0[r])); p1[r] = __builtin_amdgcn_rcpf(1.0f + __builtin_amdgcn_exp2f(p1[r])); }
        float x1[8], x0[8], GG[8], EG[8];
#pragma unroll
        for (int j = 0; j < 8; ++j) {
            const int g = j & 3; float a3, a2, a1, a0;
            if (j < 4) { a3 = p0[4 * g + 3]; a2 = p0[4 * g + 2]; a1 = p0[4 * g + 1]; a0 = p0[4 * g]; } else { a3 = p1[4 * g + 3]; a2 = p1[4 * g + 2]; a1 = p1[4 * g + 1]; a0 = p1[4 * g]; }
            x1[j] = a3 * a2; x0[j] = x1[j] * a1; const float G = x0[j] * a0;
            const float Gp = xlane_partner(G);
            GG[j] = G * Gp; EG[j] = hi ? 1.0f : Gp;
        }
        float T = R; float w[32];
#pragma unroll
        for (int j = 7; j >= 0; --j) {
            const float E = T * EG[j]; T *= GG[j];
            const int g = j & 3; float a3, a2, a1, a0;
            if (j < 4) { a3 = p0[4 * g + 3]; a2 = p0[4 * g + 2]; a1 = p0[4 * g + 1]; a0 = p0[4 * g]; } else { a3 = p1[4 * g + 3]; a2 = p1[4 * g + 2]; a1 = p1[4 * g + 1]; a0 = p1[4 * g]; }
            w[4 * j + 3] = (1.0f - a3) * E; w[4 * j + 2] = (1.0f - a2) * (E * a3); w[4 * j + 1] = (1.0f - a1) * (E * x1[j]); w[4 * j] = (1.0f - a0) * (E * x0[j]);
        }
        R = T;
#pragma unroll
        for (int ks = 0; ks < 4; ++ks) { pw[ks].x = cvtpk(w[8 * ks], w[8 * ks + 1]); pw[ks].y = cvtpk(w[8 * ks + 2], w[8 * ks + 3]); pw[ks].z = cvtpk(w[8 * ks + 4], w[8 * ks + 5]); pw[ks].w = cvtpk(w[8 * ks + 6], w[8 * ks + 7]); }
    } else {
        float a = fmaxf(fmaxf(p0[0], p0[1]), p1[0]), b = fmaxf(fmaxf(p0[2], p0[3]), p1[1]); a = fmaxf(fmaxf(a, p1[2]), p1[3]);
#pragma unroll
        for (int r = 4; r < 16; r += 4) { a = fmaxf(fmaxf(a, p0[r]), p0[r + 1]); b = fmaxf(fmaxf(b, p0[r + 2]), p0[r + 3]); a = fmaxf(fmaxf(a, p1[r]), p1[r + 1]); b = fmaxf(fmaxf(b, p1[r + 2]), p1[r + 3]); }
        float rm = fmaxf(a, b); rm = xlane_max(rm);
        if (__any(rm > thr)) {
            const float d = (thr < 0.f) ? ((rm > -INFINITY) ? rm : 0.f) : fmaxf(rm, 0.f);
            m += d;
#pragma unroll
            for (int r = 0; r < 16; ++r) { p0[r] -= d; p1[r] -= d; }
            if (thr >= 0.f) { const float f = __builtin_amdgcn_exp2f(-d); l *= f;
#pragma unroll
                for (int dg = 0; dg < NDG; ++dg)
#pragma unroll
                    for (int r = 0; r < 16; ++r) o[dg][r] *= f; }
#pragma unroll
            for (int r = 0; r < 16; ++r) negm[r] = -m;
            thr = 8.0f;
        }
        float s0 = 0.f, s1 = 0.f;
#pragma unroll
        for (int r = 0; r < 16; ++r) { p0[r] = __builtin_amdgcn_exp2f(p0[r]); p1[r] = __builtin_amdgcn_exp2f(p1[r]); s0 += p0[r]; s1 += p1[r]; }
        l += s0 + s1;
        pw[0] = (u32x4){cvtpk(p0[0], p0[1]), cvtpk(p0[2], p0[3]), cvtpk(p0[4], p0[5]), cvtpk(p0[6], p0[7])};
        pw[1] = (u32x4){cvtpk(p0[8], p0[9]), cvtpk(p0[10], p0[11]), cvtpk(p0[12], p0[13]), cvtpk(p0[14], p0[15])};
        pw[2] = (u32x4){cvtpk(p1[0], p1[1]), cvtpk(p1[2], p1[3]), cvtpk(p1[4], p1[5]), cvtpk(p1[6], p1[7])};
        pw[3] = (u32x4){cvtpk(p1[8], p1[9]), cvtpk(p1[10], p1[11]), cvtpk(p1[12], p1[13]), cvtpk(p1[14], p1[15])};
    }
    LAS const unsigned char* vp = vst + ((lane >> 4) & 1) * 32 + (lane & 3) * 8 + (4 * hi + ((lane & 15) >> 2)) * 64;
#pragma unroll
    for (int ks = 0; ks < 4; ++ks)
#pragma unroll
        for (int dg = 0; dg < NDG; ++dg) {
            const bf16x8 vf = vfrag(vp + dg * 4096 + ks * 1024);
            o[dg] = __builtin_amdgcn_mfma_f32_32x32x16_bf16(vf, __builtin_bit_cast(bf16x8, pw[ks]), o[dg], 0, 0, 0);
        }
}

template <int MODE, int NDG, int VSTRIDE>
__device__ __forceinline__ void stage2_compute(f32x16 (&o)[4], f32x16& negm, float& m, float& l, const bf16x8 (&qr)[4], LAS const unsigned char* ast, LAS const unsigned char* kst, LAS const unsigned char* vst, int r32, int hi, int lane) {
    f32x16 p[4];
    LAS const unsigned char* kp = kst + r32 * 144 + hi * 16;
#pragma unroll
    for (int i = 0; i < 4; ++i) p[i] = __builtin_amdgcn_mfma_f32_32x32x16_bf16(lds16(kp + i * 32 * 144), qr[0], negm, 0, 0, 0);
#pragma unroll
    for (int d0 = 1; d0 < 4; ++d0)
#pragma unroll
        for (int i = 0; i < 4; ++i) p[i] = __builtin_amdgcn_mfma_f32_32x32x16_bf16(lds16(kp + i * 32 * 144 + d0 * 32), qr[d0], p[i], 0, 0, 0);
    if (MODE == MODE_FOX) {
        const short one = hi ? (short)0 : (short)0x3F80;
        const bf16x8 qa = (bf16x8){one, one, one, 0, 0, 0, 0, 0};
#pragma unroll
        for (int i = 0; i < 4; ++i) p[i] = __builtin_amdgcn_mfma_f32_32x32x16_bf16(lds16(ast + (32 * i + r32) * 16), qa, p[i], 0, 0, 0);
    }
    float a = fmaxf(p[0][0], p[0][1]), b = fmaxf(p[0][2], p[0][3]);
#pragma unroll
    for (int i = 0; i < 4; ++i)
#pragma unroll
        for (int r = (i == 0 ? 4 : 0); r < 16; r += 4) { a = fmaxf(fmaxf(a, p[i][r]), p[i][r + 1]); b = fmaxf(fmaxf(b, p[i][r + 2]), p[i][r + 3]); }
    float rm = fmaxf(a, b); rm = xlane_max(rm);
    if (__any(rm > 8.0f)) {
        const float d = fmaxf(rm, 0.f), f = __builtin_amdgcn_exp2f(-d); m += d; l *= f;
#pragma unroll
        for (int i = 0; i < 4; ++i)
#pragma unroll
            for (int r = 0; r < 16; ++r) p[i][r] -= d;
#pragma unroll
        for (int dg = 0; dg < NDG; ++dg)
#pragma unroll
            for (int r = 0; r < 16; ++r) o[dg][r] *= f;
#pragma unroll
        for (int r = 0; r < 16; ++r) negm[r] = -m;
    }
    float s0 = 0.f, s1 = 0.f;
#pragma unroll
    for (int i = 0; i < 4; ++i)
#pragma unroll
        for (int r = 0; r < 16; r += 2) { p[i][r] = __builtin_amdgcn_exp2f(p[i][r]); p[i][r + 1] = __builtin_amdgcn_exp2f(p[i][r + 1]); s0 += p[i][r]; s1 += p[i][r + 1]; }
    l += s0 + s1;
    LAS const unsigned char* vp = vst + ((lane >> 4) & 1) * 32 + (lane & 3) * 8 + (4 * hi + ((lane & 15) >> 2)) * 64;
#pragma unroll
    for (int i = 0; i < 4; ++i)
#pragma unroll
        for (int j = 0; j < 2; ++j) {
            const u32x4 pw = (u32x4){cvtpk(p[i][8 * j], p[i][8 * j + 1]), cvtpk(p[i][8 * j + 2], p[i][8 * j + 3]), cvtpk(p[i][8 * j + 4], p[i][8 * j + 5]), cvtpk(p[i][8 * j + 6], p[i][8 * j + 7])};
#pragma unroll
            for (int dg = 0; dg < NDG; ++dg) {
                const bf16x8 vf = vfrag(vp + (i >> 1) * VSTRIDE + dg * 4096 + ((i & 1) * 2 + j) * 1024);
                o[dg] = __builtin_amdgcn_mfma_f32_32x32x16_bf16(vf, __builtin_bit_cast(bf16x8, pw), o[dg], 0, 0, 0);
            }
        }
}

__device__ __forceinline__ void store_o(bf16* op, const f32x16& o, float f) {
#pragma unroll
    for (int g = 0; g < 4; ++g) { u32x2 w; w.x = cvtpk(o[4 * g] * f, o[4 * g + 1] * f); w.y = cvtpk(o[4 * g + 2] * f, o[4 * g + 3] * f); *(u32x2*)(op + 8 * g) = w; }
}

__device__ __forceinline__ void fox_phase(LAS unsigned char* lds, int L) {
    constexpr int FK = 0, FV = 18432, FA = FV + 16384, FST = FA + 2048;
    const KP P = kparams(); const int tid = opaque_tid(), lane = tid & 63, wave = __builtin_amdgcn_readfirstlane(tid >> 6);
    const int r32 = lane & 31, hi = lane >> 5;
    const int bx = opaque_bx(), vcu = (bx & 7) * 32 + (bx >> 3), xcd = vcu >> 5, grp = (vcu & 31) >> 2, mi = vcu & 3;
    unsigned char* ws = P->ws;
    const bf16* Qb = (const bf16*)(ws + WS_Q); const bf16* Kb = (const bf16*)(ws + WS_K); const bf16* Vb = (const bf16*)(ws + WS_V); bf16* Ob = (bf16*)(ws + WS_O);
    LAS float* pre = (LAS float*)(lds + OFF_PRE);
    const int kvs = tid >> 3, ch = tid & 7;
    const int klds = FK + kvs * 144 + ch * 16;
    const int vkey0 = 64 * ((2 * wave) >> 3) + 16 * ((2 * wave) & 3) + (lane >> 2), vcol0 = 32 * (((2 * wave) >> 2) & 1) + 8 * (lane & 3);
    const int vlds = FV + ((2 * wave) >> 3) * 8192 + (((2 * wave) >> 2) & 1) * 4096 + ((2 * wave) & 3) * 1024 + 16 * lane;
    for (int ui = 0; ui < 4; ++ui) {
        const int bh = xcd * 16 + (ui >> 1) * 8 + grp, b = bh >> 3, hj = bh & 7, qblk = (ui & 1) ? mi : 7 - mi;
        const int col = 512 + 64 * hj;
        const size_t tokb = (size_t)b * SEQ;
        const float* clp = (const float*)(ws + WS_CL) + (size_t)(b * 8 + hj) * SEQ;
        if (!(ui & 1)) {
            if (wave == 0) { float v = (lane < 16) ? ((const float*)(ws + WS_TOT))[(b * 8 + hj) * 16 + lane] : 0.f; float inc = v;
#pragma unroll
                for (int o = 1; o < 16; o <<= 1) { const float t = shup(inc, lane, o); if (lane >= o) inc += t; }
                if (lane < 16) pre[lane] = inc - v; }
            __syncthreads();
        }
        const int q0 = 256 * qblk, NT = 2 * qblk + 2, qw0 = q0 + 32 * wave, th = (qw0 + 31) >> 6;
        bf16x8 qr[4];
        { const bf16* qp = Qb + (tokb + qw0 + r32) * 1024 + col + 8 * hi;
#pragma unroll
          for (int d0 = 0; d0 < 4; ++d0) qr[d0] = *(const bf16x8*)(qp + 16 * d0); }
        f32x16 o[4];
#pragma unroll
        for (int dg = 0; dg < 4; ++dg)
#pragma unroll
            for (int r = 0; r < 16; ++r) o[dg][r] = 0.f;
        float m = 0.f, thr = -INFINITY, l = 0.f, R = 1.0f; f32x16 negm;
#pragma unroll
        for (int r = 0; r < 16; ++r) negm[r] = 0.f;
        u32x4 kreg[2], vreg[2]; float creg = 0.f;
#define FOX_LOAD(T) do { const bf16* kg = Kb + (tokb + 128 * (T) + kvs) * 1024 + col + 8 * ch; const bf16* vg = Vb + (tokb + 128 * (T) + vkey0) * 1024 + col + vcol0; \
        kreg[0] = *(const u32x4*)(kg); kreg[1] = *(const u32x4*)(kg + 64 * 1024); vreg[0] = *(const u32x4*)(vg); vreg[1] = *(const u32x4*)(vg + 16 * 1024); \
        if (tid < 128) creg = clp[128 * (T) + tid] + pre[(T)]; } while (0)
#define FOX_STORE(sb) do { LAS unsigned char* s_ = lds + (sb) * FST; \
        *(LAS u32x4*)(s_ + klds) = kreg[0]; *(LAS u32x4*)(s_ + klds + 64 * 144) = kreg[1]; *(LAS u32x4*)(s_ + vlds) = vreg[0]; *(LAS u32x4*)(s_ + vlds + 1024) = vreg[1]; \
        if (tid < 128) { const float v_ = -creg * LOG2E; const unsigned h_ = f2bf(v_); const float r1_ = v_ - bf2f(h_); const unsigned l_ = f2bf(r1_); const float r2_ = r1_ - bf2f(l_); const unsigned l2_ = f2bf(r2_); \
            *(LAS u32x4*)(s_ + FA + tid * 16) = (u32x4){h_ | (l_ << 16), l2_, 0u, 0u}; } } while (0)
        FOX_LOAD(NT - 1); FOX_STORE(0);
        __syncthreads();
        asm volatile("" :: "v"(qr[0]), "v"(qr[1]), "v"(qr[2]), "v"(qr[3]));
        for (int it = 0; it < NT; ++it) {
            const int T = NT - 1 - it;
            if (it + 1 < NT) FOX_LOAD(T - 1);
            LAS const unsigned char* st = lds + (it & 1) * FST;
            if (2 * T + 1 <= th) tile_compute<MODE_FOX, 2>(o, negm, m, thr, l, R, qr, st + FA + 64 * 16, st + FK + 64 * 144, st + FV + 8192, 128 * T + 64, qw0, r32, hi, lane, nullptr);
            if (2 * T <= th) tile_compute<MODE_FOX, 2>(o, negm, m, thr, l, R, qr, st + FA, st + FK, st + FV, 128 * T, qw0, r32, hi, lane, nullptr);
            if (it + 1 < NT) FOX_STORE((it + 1) & 1);
            __syncthreads();
        }
#undef FOX_LOAD
#undef FOX_STORE
        const float lt = l + xlane_partner(l), f = 1.0f / lt;
        bf16* op = Ob + (tokb + qw0 + r32) * 1024 + col + 4 * hi;
        store_o(op, o[0], f); store_o(op + 32, o[1], f);
    }
}

__device__ __forceinline__ void sb_phase(LAS unsigned char* lds, int L) {
    const KP P = kparams(); const int tid = opaque_tid(), lane = tid & 63, wave = __builtin_amdgcn_readfirstlane(tid >> 6);
    const int r32 = lane & 31, hi = lane >> 5;
    const int bx = opaque_bx(), vcu = (bx & 7) * 32 + (bx >> 3), gw = vcu * 8 + wave;
    unsigned char* ws = P->ws;
    const bf16* Qb = (const bf16*)(ws + WS_Q); const bf16* Kb = (const bf16*)(ws + WS_K); const bf16* Vb = (const bf16*)(ws + WS_V); bf16* Ob = (bf16*)(ws + WS_O);
    LAS unsigned char* wl = lds + wave * 17408;
    const int kv0 = lane >> 3, ch = lane & 7;
    const unsigned klane = (unsigned)(kv0 * 1024 + 8 * ch), vlane = (unsigned)((lane >> 2) * 1024 + 8 * (lane & 3));
    const int klds = kv0 * 144 + ch * 16;
    const int vlds = 9216 + 16 * lane;
    for (int i = 0; i < 4; ++i) {
        const int id = i * 2048 + gw, bj = id >> 6, rb = id & 63, b = bj >> 3, j = bj & 7;
        const size_t tokb = (size_t)b * SEQ; const int qw0 = 32 * rb, th = (qw0 + 31) >> 6, col = 64 * j;
        bf16x8 qr[4];
        { const bf16* qp = Qb + (tokb + qw0) * 1024 + col; const unsigned ql = (unsigned)(r32 * 1024 + 8 * hi);
#pragma unroll
          for (int d0 = 0; d0 < 4; ++d0) qr[d0] = *(const bf16x8*)(qp + 16 * d0 + ql); }
        f32x16 o[4];
#pragma unroll
        for (int dg = 0; dg < 4; ++dg)
#pragma unroll
            for (int r = 0; r < 16; ++r) o[dg][r] = 0.f;
        float m = 0.f, thr = -INFINITY, l = 0.f, R = 1.0f; f32x16 negm;
#pragma unroll
        for (int r = 0; r < 16; ++r) negm[r] = 0.f;
        u32x4 kreg[8], vreg[8];
#define SB_LOAD(t) do { const bf16* kg = Kb + (tokb + 64 * (t)) * 1024 + col; const bf16* vg = Vb + (tokb + 64 * (t)) * 1024 + col; unsigned ko_ = klane, vo_ = vlane; \
        _Pragma("unroll") for (int c_ = 0; c_ < 8; ++c_) { kreg[c_] = *(const u32x4*)(kg + ko_); ko_ += 8 * 1024; asm volatile("" : "+v"(ko_)); }     \
        _Pragma("unroll") for (int c_ = 0; c_ < 8; ++c_) { vreg[c_] = *(const u32x4*)(vg + vo_); vo_ += (c_ == 3) ? 32 - 3 * 16 * 1024 : 16 * 1024; asm volatile("" : "+v"(vo_)); } } while (0)
#define SB_STORE() do { _Pragma("unroll") for (int c_ = 0; c_ < 8; ++c_) { *(LAS u32x4*)(wl + klds + c_ * 8 * 144) = kreg[c_]; *(LAS u32x4*)(wl + vlds + c_ * 1024) = vreg[c_]; } } while (0)
        SB_LOAD(th); SB_STORE();
        asm volatile("" :: "v"(qr[0]), "v"(qr[1]), "v"(qr[2]), "v"(qr[3]));
        for (int t = th; t >= 0; --t) {
            if (t > 0) SB_LOAD(t - 1);
            tile_compute<MODE_SB, 2>(o, negm, m, thr, l, R, qr, nullptr, wl, wl + 9216, 64 * t, qw0, r32, hi, lane, nullptr);
            if (!__any(R >= 1.17549435e-38f)) break;
            if (t > 0) SB_STORE();
        }
#undef SB_LOAD
#undef SB_STORE
        bf16* op = Ob + (tokb + qw0) * 1024 + col + (unsigned)(r32 * 1024 + 4 * hi);
        store_o(op, o[0], 1.0f); store_o(op + 32, o[1], 1.0f);
    }
}

__device__ __forceinline__ void diff_phase(LAS unsigned char* lds, int L) {
    constexpr int DKS = 18432, DVO = 2 * DKS, DST = DVO + 32768;
    const KP P = kparams(); const int tid = opaque_tid(), lane = tid & 63, wave = __builtin_amdgcn_readfirstlane(tid >> 6);
    const int r32 = lane & 31, hi = lane >> 5, map = wave >> 2, wq = wave & 3;
    const int bx = opaque_bx(), vcu = (bx & 7) * 32 + (bx >> 3), xcd = vcu >> 5, grp = (vcu & 31) >> 3, mi = vcu & 7, eo = L >> 1;
    unsigned char* ws = P->ws;
    const bf16* Qb = (const bf16*)(ws + WS_Q); const bf16* Kb = (const bf16*)(ws + WS_K); const bf16* Vb = (const bf16*)(ws + WS_V); bf16* Ob = (bf16*)(ws + WS_O);
    LAS float* dtab = (LAS float*)(lds + OFF_TAB);
    const float lam_init = 0.8f - 0.6f * __builtin_amdgcn_exp2f(-0.3f * LOG2E * (float)L);
    const float s1 = wave_sum(P->lq1[eo * 64 + lane] * P->lk1[eo * 64 + lane]), s2 = wave_sum(P->lq2[eo * 64 + lane] * P->lk2[eo * 64 + lane]);
    const float lam = __builtin_amdgcn_exp2f(s1 * LOG2E) - __builtin_amdgcn_exp2f(s2 * LOG2E) + lam_init;
    const int ksub = wave >> 2, krow0 = 32 * (wave & 3) + (lane >> 3);
    const int klds = ksub * DKS + krow0 * 144 + (lane & 7) * 16;
    const int vtile = wave >> 2, vdg = wave & 3, vkey0 = 64 * vtile + (lane >> 2);
    const int vlds = DVO + vtile * 16384 + vdg * 4096 + 16 * lane;
    for (int ui = 0; ui < 8; ++ui) {
        const int bh = xcd * 16 + (ui >> 1) * 4 + grp, b = bh >> 3, hj = bh & 7, qblk = (ui & 1) ? mi : 15 - mi;
        const size_t tokb = (size_t)b * SEQ;
        const int kgcol = 128 * hj + 64 * ksub + 8 * (lane & 7), vgcol = 128 * hj + 32 * vdg + 8 * (lane & 3);
        if (!(ui & 1)) {
            if (tid < 320) { const int d = 207 - tid; float v = 0.f;
                if (d < 0) v = -INFINITY;
                else if (d < 128) { int bk = d;
                    if (d >= 16) { bk = 16 + (int)(__builtin_amdgcn_logf((float)d * 0.0625f) * (16.0f / 3.0f)); bk = bk > 31 ? 31 : bk; }
                    v = (P->rel_bias[bk * 8 + hj] - P->rel_bias[31 * 8 + hj]) * LOG2E; }
                dtab[tid] = v; }
            __syncthreads();
        }
        const int q0 = 128 * qblk, NT = qblk + 1, qw0 = q0 + 32 * wq, th = (qw0 + 31) >> 6;
        bf16x8 qr[4];
        { const bf16* qp = Qb + (tokb + qw0 + r32) * 1024 + 128 * hj + 64 * map + 8 * hi;
#pragma unroll
          for (int d0 = 0; d0 < 4; ++d0) qr[d0] = *(const bf16x8*)(qp + 16 * d0); }
        f32x16 o[4];
#pragma unroll
        for (int dg = 0; dg < 4; ++dg)
#pragma unroll
            for (int r = 0; r < 16; ++r) o[dg][r] = 0.f;
        float m = 0.f, thr = -INFINITY, l = 0.f, R = 1.0f; f32x16 negm;
#pragma unroll
        for (int r = 0; r < 16; ++r) negm[r] = 0.f;
        u32x4 kreg[4], vreg[4];
#define DF_LOAD(T) do { const bf16* kg = Kb + (tokb + 128 * (T) + krow0) * 1024 + kgcol; const bf16* vg = Vb + (tokb + 128 * (T) + vkey0) * 1024 + vgcol; \
        _Pragma("unroll") for (int c_ = 0; c_ < 4; ++c_) { kreg[c_] = *(const u32x4*)(kg + c_ * 8 * 1024); vreg[c_] = *(const u32x4*)(vg + c_ * 16 * 1024); } } while (0)
#define DF_STORE(sb) do { LAS unsigned char* s_ = lds + (sb) * DST; \
        _Pragma("unroll") for (int c_ = 0; c_ < 4; ++c_) { *(LAS u32x4*)(s_ + klds + c_ * 8 * 144) = kreg[c_]; *(LAS u32x4*)(s_ + vlds + c_ * 1024) = vreg[c_]; } } while (0)
        DF_LOAD(NT - 1); DF_STORE(0);
        __syncthreads();
        asm volatile("" :: "v"(qr[0]), "v"(qr[1]), "v"(qr[2]), "v"(qr[3]));
        for (int it = 0; it < NT; ++it) {
            const int T = NT - 1 - it;
            if (it + 1 < NT) DF_LOAD(T - 1);
            LAS const unsigned char* st = lds + (it & 1) * DST; LAS const unsigned char* kst = st + map * DKS;
            if (2 * T + 1 <= th) tile_compute<MODE_DIFF, 4>(o, negm, m, thr, l, R, qr, nullptr, kst + 64 * 144, st + DVO + 16384, 128 * T + 64, qw0, r32, hi, lane, dtab);
            if (2 * T <= th) tile_compute<MODE_DIFF, 4>(o, negm, m, thr, l, R, qr, nullptr, kst, st + DVO, 128 * T, qw0, r32, hi, lane, dtab);
            if (it + 1 < NT) DF_STORE((it + 1) & 1);
            __syncthreads();
        }
#undef DF_LOAD
#undef DF_STORE
        const float lt = l + xlane_partner(l); const float f = (map ? lam : 1.0f) / lt;
        LAS float* X = (LAS float*)(lds + wq * 16384);
        if (map == 1) {
#pragma unroll
            for (int dg = 0; dg < 4; ++dg)
#pragma unroll
                for (int r = 0; r < 16; ++r) X[(dg * 16 + r) * 64 + lane] = o[dg][r] * f;
        }
        __syncthreads();
        if (map == 0) {
            float ss = 0.f;
#pragma unroll
            for (int dg = 0; dg < 4; ++dg)
#pragma unroll
                for (int r = 0; r < 16; ++r) { const float d = o[dg][r] * f - X[(dg * 16 + r) * 64 + lane]; o[dg][r] = d; ss += d * d; }
            ss += xlane_partner(ss);
            const float rn = rsqrtf(ss * (1.0f / 128.0f) + RMS_EPS) * (1.0f - lam_init);
            const float* sg = P->subln_g + eo * 128 + 4 * hi;
            bf16* orow = Ob + (tokb + qw0 + r32) * 1024 + 128 * hj + 4 * hi;
            f32x4 gv[16];
#pragma unroll
            for (int i = 0; i < 16; ++i) gv[i] = *(const f32x4*)(sg + 32 * (i >> 2) + 8 * (i & 3));
#pragma unroll
            for (int dg = 0; dg < 4; ++dg)
#pragma unroll
                for (int g = 0; g < 4; ++g) { const f32x4 gg = gv[4 * dg + g];
                    u32x2 w; w.x = cvtpk(o[dg][4 * g] * rn * gg[0], o[dg][4 * g + 1] * rn * gg[1]); w.y = cvtpk(o[dg][4 * g + 2] * rn * gg[2], o[dg][4 * g + 3] * rn * gg[3]);
                    *(u32x2*)(orow + 32 * dg + 8 * g) = w; }
        }
        __syncthreads();
    }
}
}
#define XB_TMO      128
#define XB_XCNT(j)  (256  + 64 * (j))
#define XB_XSUB(j)  (1280 + 64 * (j))
#define XB_XGEN(j)  (2304 + 64 * (j))
#define XB_TOP      3328
#define XB_TOPGEN   3392
#define XCD_BAR_WORDS 3456
#define XB_SPIN_CAP (1u << 18)

__device__ __forceinline__ unsigned xb_ld(unsigned* p)              { return __hip_atomic_load(p, __ATOMIC_RELAXED, __HIP_MEMORY_SCOPE_AGENT); }
__device__ __forceinline__ unsigned xb_add(unsigned* p, unsigned v) { return __hip_atomic_fetch_add(p, v, __ATOMIC_RELAXED, __HIP_MEMORY_SCOPE_AGENT); }
__device__ __forceinline__ unsigned xb_xcc_id() { return (unsigned)__builtin_amdgcn_s_getreg((3 << 11) | 20) & 0xFu; }
#define XB_SPIN(cond, bar) do { unsigned _sp = 0; while (cond) { __builtin_amdgcn_s_sleep(1); \
    if ((++_sp & 255u) == 0u) { if (xb_ld(&(bar)[XB_TMO])) break; if (_sp > XB_SPIN_CAP) { atomicAdd(&(bar)[XB_TMO], 1u); break; } } } } while (0)

struct XcdBarrier {
    unsigned* bar; unsigned x;
    volatile LAS unsigned* st;
};

__device__ __forceinline__ XcdBarrier xcd_barrier_post(unsigned* bar, volatile LAS unsigned* st) {
    XcdBarrier b; b.bar = bar; b.x = xb_xcc_id(); b.st = st;
    if (threadIdx.x == 0) (void)xb_add(&bar[XB_XCNT(b.x)], 1u);
    return b;
}
__device__ __forceinline__ void xcd_barrier_complete(unsigned* bar, unsigned x, unsigned& nloc, unsigned& nx) {
    const unsigned G = gridDim.x * gridDim.y * gridDim.z;
    unsigned sum, cnt, mine, sp = 0u;
    for (;;) {
        sum = 0u; cnt = 0u; mine = 0u;
#pragma unroll
        for (unsigned j = 0; j < 16; ++j) { const unsigned c = xb_ld(&bar[XB_XCNT(j)]); sum += c; cnt += (c > 0u) ? 1u : 0u; mine = (j == x) ? c : mine; }
        if (sum == G) break;
        __builtin_amdgcn_s_sleep(1);
        if ((++sp & 255u) == 0u) { if (xb_ld(&bar[XB_TMO])) break; if (sp > XB_SPIN_CAP) { atomicAdd(&bar[XB_TMO], 1u); break; } }
    }
    nloc = mine > 0u ? mine : 1u; nx = cnt > 0u ? cnt : 1u;
}

__device__ __forceinline__ void xcd_barrier(const XcdBarrier& b) {
    asm volatile("s_waitcnt vmcnt(0)" ::: "memory");
    __syncthreads();
    if (threadIdx.x == 0) {
        unsigned* bar = b.bar; unsigned bx_ = b.x;
        asm volatile("" : "+s"(bar), "+s"(bx_));
        __builtin_amdgcn_s_waitcnt(0);
        unsigned nloc = b.st[0], nx = b.st[1];
        if (nloc == 0u) { xcd_barrier_complete(bar, bx_, nloc, nx); b.st[0] = nloc; b.st[1] = nx; }
        const unsigned old = xb_add(&bar[XB_XSUB(bx_)], 1u);
        const unsigned gen = old / nloc;
        if (old + 1u == (gen + 1u) * nloc) {
            __builtin_amdgcn_fence(__ATOMIC_RELEASE, "agent");
            asm volatile("s_waitcnt vmcnt(0)" ::: "memory");
            const unsigned og = xb_add(&bar[XB_TOP], 1u);
            const unsigned tg = og / nx;
            if (og + 1u == (tg + 1u) * nx) xb_add(&bar[XB_TOPGEN], 1u);
            else XB_SPIN(xb_ld(&bar[XB_TOPGEN]) == tg, bar);
            __builtin_amdgcn_fence(__ATOMIC_ACQUIRE, "agent");
            xb_add(&bar[XB_XGEN(bx_)], 1u);
            asm volatile("s_waitcnt vmcnt(0)" ::: "memory");
        } else {
            XB_SPIN(xb_ld(&bar[XB_XGEN(bx_)]) == gen, bar);
            __builtin_amdgcn_fence(__ATOMIC_ACQUIRE, "agent");
            asm volatile("s_waitcnt vmcnt(0)" ::: "memory");
        }
    }
    __syncthreads();
}

constexpr int LDS_BYTES = att::ATT_LDS;
__global__ void __launch_bounds__(512, 2) fwd_kernel(Params P) {
    extern __shared__ __attribute__((aligned(16))) unsigned char lds_raw[];
    LAS unsigned char* lds = (LAS unsigned char*)lds_raw;
    cg::grid_group grid = cg::this_grid();
    unsigned* barw = (unsigned*)(kparams()->ws + WS_BAR);
    { const int t0 = opaque_tid(); if (blockIdx.x == 0) for (int i = t0; i < XCD_BAR_WORDS; i += 512) barw[i] = 0u;
      if (t0 < 16) ((LAS unsigned*)(lds + att::OFF_MISC))[t0] = 0u; }
#ifndef SKIP_P0
    p0_prologue(lds);
#endif
#ifdef PROBE_P02
    __syncthreads(); p0_prologue(lds);
#endif
    grid.sync();
    const XcdBarrier xbar = xcd_barrier_post(barw, (volatile LAS unsigned*)(lds + att::OFF_MISC));
#pragma unroll 1
    for (int L = 0; L < DEPTH; ++L) {
        const int odd = L & 1, eo = L >> 1;
#ifndef SKIP_FG
        if (!odd) fg_phase(lds, L);
#endif
#ifdef PROBE_FG2
        if (!odd) fg_phase(lds, L);
#endif
        {
            const KP P = kparams(); unsigned char* ws = P->ws;
            pg8::Gemm g{(const bf16*)(ws + WS_XB), (const bf16*)(ws + WS_W + (size_t)L * W_LAYER + W_IN), MTOK, 3072, 1024}; pg8::StaticOrder S; S.init(MTOK, 3072, 256, opaque_bx());
            pg8::EpiQKV E{(bf16*)(ws + WS_Q), (const float*)(ws + WS_SSQA), (odd ? P->diff_gq : P->fox_gq) + eo * 64, (odd ? P->diff_gk : P->fox_gk) + eo * 64, odd};
#ifndef SKIP_G1
            pg8::gemm_phase<pg8::EpiQKV, pg8::StaticOrder, PG8_ALIGN, PG8_SP2>(lds, g, S, E);
#endif
#ifdef PROBE_QKV2
            pg8::gemm_phase<pg8::EpiQKV, pg8::StaticOrder, PG8_ALIGN, PG8_SP2>(lds, g, S, E);
#endif
        }
        xcd_barrier(xbar);
#ifdef PROBE_PRIO
        if (opaque_tid() >= 256) __builtin_amdgcn_s_setprio(1);
#endif
#ifndef SKIP_DIFF
        if (odd) att::diff_phase(lds, L);
#endif
#ifdef PROBE_DIFF2
        if (odd) { __syncthreads(); att::diff_phase(lds, L); }
#endif
#ifdef PROBE_FOX2
        if (!odd) { att::fox_phase(lds, L); __syncthreads(); }
#endif
#ifdef PROBE_SB2
        if (!odd) { att::sb_phase(lds, L); __syncthreads(); }
#endif
#ifdef PROBE_EVEN2
        if (!odd) { att::fox_phase(lds, L); att::sb_phase(lds, L); __syncthreads(); }
#endif
#ifndef SKIP_FOX
        if (!odd) att::fox_phase(lds, L);
#endif
#ifndef SKIP_SB
        if (!odd) att::sb_phase(lds, L);
#endif
#ifdef PROBE_PRIO
        __builtin_amdgcn_s_setprio(0);
#endif
        xcd_barrier(xbar);
        {
            const KP P = kparams(); unsigned char* ws = P->ws;
            pg8::Gemm g{(const bf16*)(ws + WS_O), (const bf16*)(ws + WS_W + (size_t)L * W_LAYER + W_O), MTOK, 1024, 1024}; pg8::StaticOrder S; S.init(MTOK, 1024, 256, opaque_bx());
            pg8::EpiResid E{(bf16*)(ws + WS_XB), P->out, (float*)(ws + WS_SSQF), 0};
#ifndef SKIP_G2
            pg8::gemm_phase<pg8::EpiResid, pg8::StaticOrder, PG8_ALIGN, PG8_SP2>(lds, g, S, E);
#endif
        }
        xcd_barrier(xbar);
        {
            const KP P = kparams(); unsigned char* ws = P->ws;
            pg8::Gemm g{(const bf16*)(ws + WS_XB), (const bf16*)(ws + WS_W + (size_t)L * W_LAYER + W_GU), MTOK, 2 * DFF, 1024}; pg8::StaticOrder S; S.init(MTOK, 2 * DFF, 256, opaque_bx());
            pg8::EpiSwiGLU E{(bf16*)(ws + WS_H), (const float*)(ws + WS_SSQF)};
#ifndef SKIP_G3
            pg8::gemm_phase<pg8::EpiSwiGLU, pg8::StaticOrder, PG8_ALIGN, PG8_SP2>(lds, g, S, E);
#endif
#ifdef PROBE_GU2
            pg8::gemm_phase<pg8::EpiSwiGLU, pg8::StaticOrder, PG8_ALIGN, PG8_SP2>(lds, g, S, E);
#endif
        }
        xcd_barrier(xbar);
        {
            const KP P = kparams(); unsigned char* ws = P->ws;
            pg8::Gemm g{(const bf16*)(ws + WS_H), (const bf16*)(ws + WS_W + (size_t)L * W_LAYER + W_D), MTOK, 1024, DFF}; pg8::StaticOrder S; S.init(MTOK, 1024, 256, opaque_bx());
            pg8::EpiResid E{(bf16*)(ws + WS_XB), P->out, (float*)(ws + WS_SSQA), L == DEPTH - 1};
#ifndef SKIP_G4
            pg8::gemm_phase<pg8::EpiResid, pg8::StaticOrder, PG8_ALIGN, PG8_SP2>(lds, g, S, E);
#endif
        }
        if (L + 1 < DEPTH) xcd_barrier(xbar);
#ifdef PROBE_BAR2
        for (int rep = 0; rep < 5; ++rep) xcd_barrier(xbar);
#endif
    }
}

extern "C" void kernel_launch(void* const* d_in, const int* in_sizes, int n_in, void* d_out, int out_size, void* d_ws, size_t ws_size, hipStream_t stream) {
    static int grid = 0;
    if (grid == 0) {
        if (n_in != 21 || in_sizes[0] != MTOK * DMODEL || out_size != MTOK * DMODEL || ws_size < WS_END) { fprintf(stderr, "kernel_launch: unexpected shapes (n_in %d, in0 %d, out %d, ws %zu)\n", n_in, n_in > 0 ? in_sizes[0] : -1, out_size, ws_size); grid = -1; return; }
        int dev = 0, cus = 0, per_cu = 0;
        hipGetDevice(&dev); hipDeviceGetAttribute(&cus, hipDeviceAttributeMultiprocessorCount, dev);
        if (hipFuncSetAttribute((const void*)fwd_kernel, hipFuncAttributeMaxDynamicSharedMemorySize, LDS_BYTES) != hipSuccess) { fprintf(stderr, "kernel_launch: hipFuncSetAttribute failed\n"); grid = -1; return; }
        hipOccupancyMaxActiveBlocksPerMultiprocessor(&per_cu, (const void*)fwd_kernel, 512, LDS_BYTES);
        if (cus * per_cu < 256) { fprintf(stderr, "kernel_launch: device holds only %d x %d resident workgroups, need 256\n", cus, per_cu); grid = -1; return; }
        grid = 256;
    }
    if (grid < 0) return;
    Params p{};
    const float** f = (const float**)&p;
    for (int i = 0; i < 21; ++i) f[i] = (const float*)d_in[i];
    p.out = (float*)d_out; p.ws = (unsigned char*)d_ws;
    void* args[] = {&p};
    hipError_t e = hipLaunchCooperativeKernel((const void*)fwd_kernel, dim3(grid), dim3(512), args, LDS_BYTES, stream);
    if (e != hipSuccess) fprintf(stderr, "cooperative launch failed: %s\n", hipGetErrorString(e));
}
```
